# Optimizing an MI355X kernel written in HIP

```python
import jax, jax.numpy as jnp
from jax import lax
import numpy as np

D_MODEL = 1024
BATCH = 2
SEQ = 8192
DEPTH = 2

CHUNK = 64
MIX_WIDTH = D_MODEL
CONV_WIDTH = MIX_WIDTH // 2
RET_WIDTH = MIX_WIDTH - CONV_WIDTH
RET_HEADS = 4
RET_HEAD_DIM = RET_WIDTH // RET_HEADS
CONV_KERNEL = 31
D_FF = 4 * D_MODEL
ROPE_BASE = 10000.0
EPS = 1e-6
IN_WIDTH = 2 * CONV_WIDTH + 4 * RET_WIDTH

kernel_name = "hybrid_conv_retention_encoder"


def rms_norm(x, g):
    xf = x.astype(jnp.float32)
    y = xf * lax.rsqrt(jnp.mean(xf * xf, axis=-1, keepdims=True) + EPS)
    return (y * g.astype(jnp.float32)).astype(x.dtype)


def layer_norm(x, g, b):
    xf = x.astype(jnp.float32)
    mu = jnp.mean(xf, axis=-1, keepdims=True)
    var = jnp.mean(jnp.square(xf - mu), axis=-1, keepdims=True)
    y = (xf - mu) * lax.rsqrt(var + EPS)
    return (y * g.astype(jnp.float32) + b.astype(jnp.float32)).astype(x.dtype)


def conv_group(u, w_dw, b_dw, ln_g, ln_b):
    a, gate = jnp.split(u, 2, axis=-1)
    h = a * jax.nn.sigmoid(gate)
    h = lax.conv_general_dilated(
        h, w_dw[:, None, :], window_strides=(1,),
        padding=[(CONV_KERNEL - 1, 0)],
        dimension_numbers=("NWC", "WIO", "NWC"),
        feature_group_count=CONV_WIDTH) + b_dw
    h = layer_norm(h, ln_g, ln_b)
    return jax.nn.silu(h)


def rotary(x, cos, sin):
    x1, x2 = jnp.split(x, 2, axis=-1)
    c = cos[None, :, None, :]
    s = sin[None, :, None, :]
    return jnp.concatenate([x1 * c - x2 * s, x1 * s + x2 * c], axis=-1)


def chunk_retention(q, k, v):
    b, s, h, d = q.shape
    n = s // CHUNK
    dt = q.dtype
    q = q.reshape(b, n, CHUNK, h, d)
    k = k.reshape(b, n, CHUNK, h, d)
    v = v.reshape(b, n, CHUNK, h, d)
    log_gamma = jnp.log(1.0 - jnp.exp2(-5.0 - jnp.arange(h, dtype=jnp.float32)))
    idx = jnp.arange(CHUNK, dtype=jnp.float32)
    dist = jnp.abs(idx[:, None] - idx[None, :])
    d_intra = jnp.exp(log_gamma[:, None, None] * dist[None]).astype(dt)
    w_key = jnp.exp(log_gamma[:, None] * (CHUNK - 1 - idx)[None]).astype(dt)
    w_qry = jnp.exp(log_gamma[:, None] * (idx + 1.0)[None]).astype(dt)
    g_chunk = jnp.exp(log_gamma * CHUNK).astype(dt)[None, :, None, None]

    scores = jnp.einsum("bnihd,bnjhd->bnhij", q, k) * d_intra
    o_intra = jnp.einsum("bnhij,bnjhe->bnihe", scores, v)

    kv = jnp.einsum("bnjhd,hj,bnjhe->nbhde", k, w_key, v)

    def step(state, kv_c):
        return state * g_chunk + kv_c, state

    _, s_prev = lax.scan(step, jnp.zeros((b, h, d, d), dt), kv)
    o_inter = jnp.einsum("bnihd,hi,nbhde->bnihe", q, w_qry, s_prev)
    return (o_intra + o_inter).reshape(b, s, h, d)


def retention_group(q, k, v, g, norm_g, cos, sin):
    b, s, _ = q.shape
    q = rotary(q.reshape(b, s, RET_HEADS, RET_HEAD_DIM), cos, sin)
    k = rotary(k.reshape(b, s, RET_HEADS, RET_HEAD_DIM), cos, sin) * (RET_HEAD_DIM ** -0.5)
    v = v.reshape(b, s, RET_HEADS, RET_HEAD_DIM)
    o = chunk_retention(q, k, v)
    o = rms_norm(o, norm_g.reshape(RET_HEADS, RET_HEAD_DIM))
    return o.reshape(b, s, RET_WIDTH) * jax.nn.silu(g)


def setup_inputs(seed: int = 0) -> dict:
    key = jax.random.key(seed)
    ks = jax.random.split(key, 16)
    f32 = jnp.float32
    nrm = lambda k, shape, scale: jax.random.normal(k, shape, f32) * scale
    return {
        "x": nrm(ks[0], (BATCH, SEQ, D_MODEL), 1.0),
        "norm1_g": 1.0 + nrm(ks[1], (DEPTH, D_MODEL), 0.02),
        "w_in": nrm(ks[2], (DEPTH, D_MODEL, IN_WIDTH), D_MODEL ** -0.5),
        "conv_w": nrm(ks[3], (DEPTH, CONV_KERNEL, CONV_WIDTH), CONV_KERNEL ** -0.5),
        "conv_b": nrm(ks[4], (DEPTH, CONV_WIDTH), 0.02),
        "conv_ln_g": 1.0 + nrm(ks[5], (DEPTH, CONV_WIDTH), 0.02),
        "conv_ln_b": nrm(ks[6], (DEPTH, CONV_WIDTH), 0.02),
        "ret_norm_g": 1.0 + nrm(ks[7], (DEPTH, RET_WIDTH), 0.02),
        "w_out": nrm(ks[8], (DEPTH, MIX_WIDTH, D_MODEL), MIX_WIDTH ** -0.5),
        "norm2_g": 1.0 + nrm(ks[9], (DEPTH, D_MODEL), 0.02),
        "w_ff1": nrm(ks[10], (DEPTH, D_MODEL, D_FF), D_MODEL ** -0.5),
        "w_ff2": nrm(ks[11], (DEPTH, D_FF, D_MODEL), D_FF ** -0.5),
        "final_g": 1.0 + nrm(ks[12], (D_MODEL,), 0.02),
    }


def reference(x, norm1_g, w_in, conv_w, conv_b, conv_ln_g, conv_ln_b, ret_norm_g,
              w_out, norm2_g, w_ff1, w_ff2, final_g):
    s = x.shape[1]
    pos = jnp.arange(s, dtype=jnp.float32)
    inv_freq = ROPE_BASE ** (-jnp.arange(0, RET_HEAD_DIM, 2, dtype=jnp.float32) / RET_HEAD_DIM)
    ang = pos[:, None] * inv_freq[None, :]
    cos = jnp.cos(ang).astype(x.dtype)
    sin = jnp.sin(ang).astype(x.dtype)
    split_at = [2 * CONV_WIDTH + i * RET_WIDTH for i in range(4)]

    for l in range(DEPTH):
        h = rms_norm(x, norm1_g[l])
        u = h @ w_in[l]
        u_conv, q, k, v, g = jnp.split(u, split_at, axis=-1)
        a_out = conv_group(u_conv, conv_w[l], conv_b[l], conv_ln_g[l], conv_ln_b[l])
        b_out = retention_group(q, k, v, g, ret_norm_g[l], cos, sin)
        x = x + jnp.concatenate([a_out, b_out], axis=-1) @ w_out[l]
        h = rms_norm(x, norm2_g[l])
        x = x + jnp.square(jax.nn.relu(h @ w_ff1[l])) @ w_ff2[l]
    return rms_norm(x, final_g)
```

```cpp
#include <hip/hip_runtime.h>
#include <hip/hip_cooperative_groups.h>
#include <cstdio>
#include <cstdint>
namespace cg = cooperative_groups;
namespace pg8 {
#define PG8_LAS __attribute__((address_space(3)))
typedef unsigned short bf16_t;
typedef short bf16x8 __attribute__((ext_vector_type(8)));
typedef float f32x4 __attribute__((ext_vector_type(4)));
typedef unsigned u32x4 __attribute__((ext_vector_type(4)));
constexpr int BM = 256, BK = 64, HALF = 128, HTB = HALF * BK * 2  , STAGE_BYTES = 8 * HTB, NXCD = 8, WGM = 8;

__host__ __device__ __forceinline__ int lds_byte(int r, int c) { const int st = (r >> 4) * 2 + (c >> 5), rr = r & 15, cc = c & 31, ob = rr * 64 + cc * 2; return st * 1024 + (ob ^ (((ob >> 9) & 1) << 5)); }
__host__ __device__ __forceinline__ void stage_rc(int b, int& R, int& C) { const int st = b / 1024, sb = b % 1024, swz = sb ^ (((sb >> 9) & 1) << 5); R = (st >> 1) * 16 + swz / 64; C = (st & 1) * 32 + (swz % 64) / 2; }
__host__ __device__ __forceinline__ int perm32(int rho) { const int n = rho >> 4, i = rho & 15; return 8 * (i >> 2) + 4 * n + (i & 3); }

struct Unit { int pm, pn; };
struct Gemm { const bf16_t* A; const bf16_t* Bt; int M, N, K; };

struct StaticOrder {
    int nM, nN, nwg, G, c;
    __host__ __device__ void init(int M, int N, int G_, int c_) { nM = M / BM; nN = N / BM; nwg = nM * nN; G = G_; c = c_; }
    __host__ __device__ bool next(int i, Unit& u) const {
        const long L = (long)i * G + c; if (L >= nwg) return false;
        int wgid = (int)L; { const int q = nwg / NXCD, r = nwg % NXCD, xcd = wgid % NXCD, off = wgid / NXCD; wgid = (xcd < r ? xcd * (q + 1) : r * (q + 1) + (xcd - r) * q) + off; }
        const int nig = WGM * nN, gid = wgid / nig, fm = gid * WGM, gsz = (nM - fm) < WGM ? (nM - fm) : WGM;
        u.pm = fm + ((wgid % nig) % gsz); u.pn = (wgid % nig) / gsz; return true;
    }
    __device__ __forceinline__ void a_ready(const Unit&) const {}
    __device__ __forceinline__ void done(const Unit&) const {}
};
__device__ __forceinline__ unsigned cvt_pk_bf16(float lo, float hi) { unsigned r; asm volatile("v_cvt_pk_bf16_f32 %0, %1, %2" : "=v"(r) : "v"(lo), "v"(hi)); return r; }
typedef float f32x2 __attribute__((ext_vector_type(2)));
constexpr float RMS_EPS = 1e-6f;
template <int ACT> struct EpiScale {
    static constexpr bool PERM = true, AFTER_DRAIN = false;
    bf16_t* O; int ldc; const float* ssq;
    __device__ __forceinline__ void operator()(const f32x4 (&acc)[2][2][4][2], const Unit& u, int wr, int wc, int fr, int fq) const {
        const int row0 = u.pm * BM + wr * 64 + fr; const int col0 = u.pn * BM + wc * 32 + 8 * fq;
#pragma unroll
        for (int ai = 0; ai < 2; ++ai)
#pragma unroll
            for (int m = 0; m < 4; ++m) { const int row = row0 + ai * HALF + m * 16; const float rs = __builtin_amdgcn_rsqf(ssq[row] * (1.0f / 1024.0f) + RMS_EPS);
                bf16_t* rowp = O + (size_t)row * ldc + col0;
#pragma unroll
                for (int bj = 0; bj < 2; ++bj) { f32x4 v0 = acc[ai][bj][m][0] * rs, v1 = acc[ai][bj][m][1] * rs;
                    if (ACT == 1) {
#pragma unroll
                        for (int t = 0; t < 4; ++t) { float a = v0[t] > 0.f ? v0[t] : 0.f; v0[t] = a * a; float b = v1[t] > 0.f ? v1[t] : 0.f; v1[t] = b * b; } }
                    u32x4 w; w.x = cvt_pk_bf16(v0[0], v0[1]); w.y = cvt_pk_bf16(v0[2], v0[3]); w.z = cvt_pk_bf16(v1[0], v1[1]); w.w = cvt_pk_bf16(v1[2], v1[3]);
                    *(u32x4*)(rowp + bj * HALF) = w; } }
    }
};
struct EpiResid {
    static constexpr bool PERM = true, AFTER_DRAIN = false;
    const float* xin; float* xout; bf16_t* xb; float* ssq_out;
    __device__ __forceinline__ void operator()(const f32x4 (&acc)[2][2][4][2], const Unit& u, int wr, int wc, int fr, int fq) const {
        const int row0 = u.pm * BM + wr * 64 + fr; const int col0 = u.pn * BM + wc * 32 + 8 * fq;
#pragma unroll
        for (int ai = 0; ai < 2; ++ai)
#pragma unroll
            for (int m = 0; m < 4; ++m) { const int row = row0 + ai * HALF + m * 16; const size_t off = (size_t)row * 1024 + col0; float q = 0.f;
#pragma unroll
                for (int bj = 0; bj < 2; ++bj) { const f32x4 r0 = *(const f32x4*)(xin + off + bj * HALF), r1 = *(const f32x4*)(xin + off + bj * HALF + 4);
                    const f32x4 v0 = acc[ai][bj][m][0] + r0, v1 = acc[ai][bj][m][1] + r1;
                    *(f32x4*)(xout + off + bj * HALF) = v0; *(f32x4*)(xout + off + bj * HALF + 4) = v1;
                    u32x4 w; w.x = cvt_pk_bf16(v0[0], v0[1]); w.y = cvt_pk_bf16(v0[2], v0[3]); w.z = cvt_pk_bf16(v1[0], v1[1]); w.w = cvt_pk_bf16(v1[2], v1[3]);
                    *(u32x4*)(xb + off + bj * HALF) = w;
                    q += (v0[0] * v0[0] + v0[1] * v0[1]) + (v0[2] * v0[2] + v0[3] * v0[3]) + (v1[0] * v1[0] + v1[1] * v1[1]) + (v1[2] * v1[2] + v1[3] * v1[3]); }
                q += __shfl_xor(q, 16); q += __shfl_xor(q, 32);
                if (fq == 0) unsafeAtomicAdd(ssq_out + row, q); }
    }
};
template <class Epi, class Sched, bool ALIGN_EPI = false, bool SP2 = false>
__device__ __forceinline__ void gemm_phase(PG8_LAS unsigned char* lds, const Gemm g, const Sched& S, const Epi& E, const int tid) {
    const int wid = __builtin_amdgcn_readfirstlane(tid >> 6), lane = tid & 63, wr = wid >> 2, wc = wid & 3, fr = lane & 15, fq = lane >> 4;
    const int K = g.K, nt = K / BK;
    unsigned voffA[2], voffB[2];
#pragma unroll
    for (int i = 0; i < 2; ++i) { int R, C; stage_rc(tid * 16 + i * 8192, R, C); const int Rb = Epi::PERM ? ((R & ~31) + perm32(R & 31)) : R;
        voffA[i] = (unsigned)(R * K + C) * 2u; voffB[i] = (unsigned)(Rb * K + C) * 2u; }
    const size_t kstep = (size_t)(BK * 2);
    const size_t hstep = (size_t)HALF * K * 2;
    const size_t tstep = 2 * hstep;
    const unsigned ldsw = (unsigned)wid * 1024u;
    const int aoff = lds_byte(wr * 64 + fr, fq * 8), boff = lds_byte(wc * 32 + fr, fq * 8);
#define PG8_SA(b, h) (((b) * 2 + (h)) * HTB)
#define PG8_SB(b, h) ((4 + (b) * 2 + (h)) * HTB)
#define PG8_STAGE(bufoff, gbase, voff) do { _Pragma("unroll") for (int _i = 0; _i < 2; ++_i) \
        __builtin_amdgcn_global_load_lds((const unsigned*)((const char*)(gbase) + (voff)[_i]), (PG8_LAS unsigned*)(lds + (bufoff) + ldsw + _i * 8192), 16, 0, 0); } while (0)
#define PG8_LDA(dst, b, h) do { _Pragma("unroll") for (int m = 0; m < 4; ++m) _Pragma("unroll") for (int k = 0; k < 2; ++k) dst[m][k] = *(const PG8_LAS bf16x8*)(lds + PG8_SA(b, h) + aoff + m * 2048 + k * 1024); } while (0)
#define PG8_LDB(dst, b, h) do { _Pragma("unroll") for (int n = 0; n < 2; ++n) _Pragma("unroll") for (int k = 0; k < 2; ++k) dst[n][k] = *(const PG8_LAS bf16x8*)(lds + PG8_SB(b, h) + boff + n * 2048 + k * 1024); } while (0)
#define PG8_MMA(ai, bj, At, Bt) do { __builtin_amdgcn_s_setprio(1); _Pragma("unroll") for (int m = 0; m < 4; ++m) _Pragma("unroll") for (int n = 0; n < 2; ++n) _Pragma("unroll") for (int k = 0; k < 2; ++k) \
        acc[ai][bj][m][n] = __builtin_amdgcn_mfma_f32_16x16x32_bf16(Bt[n][k], At[m][k], acc[ai][bj][m][n], 0, 0, 0); __builtin_amdgcn_s_setprio(0); } while (0)
#define PG8_WAIT_V(n) asm volatile("s_waitcnt vmcnt(" #n ")" ::: "memory")
#define PG8_WAIT_L(n) asm volatile("s_waitcnt lgkmcnt(" #n ")" ::: "memory")
#define PG8_BAR __builtin_amdgcn_s_barrier()
#define PG8_SCHED __builtin_amdgcn_sched_barrier(0)
    Unit cur, nxt; int ui = 0;
    if (!S.next(0, cur)) return;
    f32x4 acc[2][2][4][2];
#pragma unroll
    for (int a = 0; a < 2; ++a)
#pragma unroll
        for (int b = 0; b < 2; ++b)
#pragma unroll
            for (int m = 0; m < 4; ++m)
#pragma unroll
                for (int n = 0; n < 2; ++n) acc[a][b][m][n] = (f32x4){0.f, 0.f, 0.f, 0.f};
    bf16x8 At[4][2], B0[2][2], B1[2][2];
    const char* cA = (const char*)g.A + (size_t)cur.pm * tstep; const char* cB = (const char*)g.Bt + (size_t)cur.pn * tstep;
    S.a_ready(cur);
    if constexpr (SP2) {
        PG8_STAGE(PG8_SB(0, 0), cB, voffB); PG8_STAGE(PG8_SB(0, 1), cB + hstep, voffB); PG8_STAGE(PG8_SA(0, 0), cA, voffA); PG8_STAGE(PG8_SA(0, 1), cA + hstep, voffA);
        if (wr == 1) PG8_BAR;
        PG8_WAIT_V(2); PG8_BAR;
        PG8_STAGE(PG8_SB(1, 0), cB + kstep, voffB); PG8_STAGE(PG8_SA(1, 0), cA + kstep, voffA); PG8_STAGE(PG8_SB(1, 1), cB + hstep + kstep, voffB);
        PG8_WAIT_V(6); PG8_BAR;
    } else {
        PG8_STAGE(PG8_SB(0, 0), cB, voffB); PG8_STAGE(PG8_SA(0, 0), cA, voffA); PG8_STAGE(PG8_SB(0, 1), cB + hstep, voffB); PG8_STAGE(PG8_SA(0, 1), cA + hstep, voffA);
        if (wr == 1) PG8_BAR;
        PG8_WAIT_V(4); PG8_BAR;
        PG8_STAGE(PG8_SB(1, 0), cB + kstep, voffB); PG8_STAGE(PG8_SA(1, 0), cA + kstep, voffA); PG8_STAGE(PG8_SB(1, 1), cB + hstep + kstep, voffB);
        PG8_WAIT_V(6); PG8_BAR;
    }
    for (;;) {
        const bool has_next = S.next(ui + 1, nxt);
        const char* nA = has_next ? (const char*)g.A + (size_t)nxt.pm * tstep : cA; const char* nB = has_next ? (const char*)g.Bt + (size_t)nxt.pn * tstep : cB;
        for (int t = 0; t < nt; t += 2) {
            const bool last = (t == nt - 2);
            const char* a1 = cA + (size_t)(t + 1) * kstep;
            const char* a2 = last ? nA : cA + (size_t)(t + 2) * kstep; const char* b2 = last ? nB : cB + (size_t)(t + 2) * kstep;
            const char* a3 = a2 + kstep; const char* b3 = b2 + kstep;
            if (last && has_next) S.a_ready(nxt);
            if constexpr (SP2) {
            PG8_LDB(B0, 0, 0); PG8_LDB(B1, 0, 1); PG8_SCHED; PG8_LDA(At, 0, 0); PG8_STAGE(PG8_SA(1, 1), a1 + hstep, voffA);
            PG8_WAIT_V(8); PG8_WAIT_L(0); PG8_BAR; PG8_MMA(0, 0, At, B0); PG8_MMA(0, 1, At, B1); PG8_BAR; PG8_SCHED;
            PG8_LDA(At, 0, 1); PG8_STAGE(PG8_SB(0, 0), b2, voffB); PG8_STAGE(PG8_SB(0, 1), b2 + hstep, voffB); PG8_STAGE(PG8_SA(0, 0), a2, voffA);
            PG8_WAIT_V(8); PG8_WAIT_L(0); PG8_BAR; PG8_MMA(1, 0, At, B0); PG8_MMA(1, 1, At, B1); PG8_BAR; PG8_SCHED;
            PG8_LDB(B0, 1, 0); PG8_LDB(B1, 1, 1); PG8_SCHED; PG8_LDA(At, 1, 0); PG8_STAGE(PG8_SA(0, 1), a2 + hstep, voffA);
            PG8_WAIT_V(8); PG8_WAIT_L(0); PG8_BAR; PG8_MMA(0, 0, At, B0); PG8_MMA(0, 1, At, B1); PG8_BAR; PG8_SCHED;
            PG8_LDA(At, 1, 1); PG8_STAGE(PG8_SB(1, 0), b3, voffB); PG8_STAGE(PG8_SB(1, 1), b3 + hstep, voffB); PG8_STAGE(PG8_SA(1, 0), a3, voffA);
            PG8_WAIT_V(8); PG8_WAIT_L(0); PG8_BAR; PG8_MMA(1, 0, At, B0); PG8_MMA(1, 1, At, B1); PG8_BAR; PG8_SCHED;
            } else {
            PG8_LDB(B0, 0, 0); PG8_SCHED; PG8_LDA(At, 0, 0); PG8_STAGE(PG8_SA(1, 1), a1 + hstep, voffA);
            PG8_WAIT_L(8); PG8_BAR; PG8_WAIT_L(0); PG8_MMA(0, 0, At, B0); PG8_BAR; PG8_SCHED;
            PG8_LDB(B1, 0, 1); PG8_STAGE(PG8_SB(0, 0), b2, voffB);
            PG8_BAR; PG8_WAIT_L(0); PG8_MMA(0, 1, At, B1); PG8_BAR;
            PG8_LDA(At, 0, 1); PG8_STAGE(PG8_SA(0, 0), a2, voffA);
            PG8_BAR; PG8_WAIT_L(0); PG8_MMA(1, 0, At, B0); PG8_BAR; PG8_SCHED;
            PG8_STAGE(PG8_SB(0, 1), b2 + hstep, voffB);
            PG8_WAIT_V(6); PG8_BAR; PG8_MMA(1, 1, At, B1); PG8_BAR;
            PG8_LDB(B0, 1, 0); PG8_SCHED; PG8_LDA(At, 1, 0); PG8_STAGE(PG8_SA(0, 1), a2 + hstep, voffA);
            PG8_WAIT_L(8); PG8_BAR; PG8_WAIT_L(0); PG8_MMA(0, 0, At, B0); PG8_BAR; PG8_SCHED;
            PG8_LDB(B1, 1, 1); PG8_STAGE(PG8_SB(1, 0), b3, voffB);
            PG8_BAR; PG8_WAIT_L(0); PG8_MMA(0, 1, At, B1); PG8_BAR;
            PG8_LDA(At, 1, 1); PG8_STAGE(PG8_SA(1, 0), a3, voffA);
            PG8_BAR; PG8_WAIT_L(0); PG8_MMA(1, 0, At, B0); PG8_BAR; PG8_SCHED;
            PG8_STAGE(PG8_SB(1, 1), b3 + hstep, voffB);
            PG8_WAIT_V(6); PG8_BAR; PG8_MMA(1, 1, At, B1); PG8_BAR;
            }
        }
        if constexpr (ALIGN_EPI) { if (wr == 0) PG8_BAR; }
        if constexpr (!Epi::AFTER_DRAIN) { E(acc, cur, wr, wc, fr, fq); S.done(cur); }
        if (!has_next) break;
#pragma unroll
        for (int a = 0; a < 2; ++a)
#pragma unroll
            for (int b = 0; b < 2; ++b)
#pragma unroll
                for (int m = 0; m < 4; ++m)
#pragma unroll
                    for (int n = 0; n < 2; ++n) acc[a][b][m][n] = (f32x4){0.f, 0.f, 0.f, 0.f};
        cur = nxt; cA = nA; cB = nB; ++ui;
        if constexpr (ALIGN_EPI) { if (wr == 1) PG8_BAR; }
    }
    PG8_WAIT_V(0);
    if constexpr (!ALIGN_EPI) { if (wr == 0) PG8_BAR; }
    PG8_BAR;
    if constexpr (Epi::AFTER_DRAIN) { E.fused(acc, cur, wr, wc, fr, fq, lds, wid, lane); S.done(cur); }
#undef PG8_SA
#undef PG8_SB
#undef PG8_STAGE
#undef PG8_LDA
#undef PG8_LDB
#undef PG8_MMA
#undef PG8_WAIT_V
#undef PG8_WAIT_L
#undef PG8_BAR
#undef PG8_SCHED
}
}
constexpr int NWAVES = 8, NT = 512;
constexpr int BATCH = 2, SEQ = 8192, DM = 1024, DEPTH = 2, FF = 4096, INW = 3072, CW = 512, NH = 4, HD = 128, CK = 31;
constexpr int M = BATCH * SEQ;
constexpr int U_Q = 1024, U_K = 1536, U_V = 2048, U_G = 2560;
constexpr int NSUP = SEQ / 256;
constexpr size_t MiB = 1u << 20;
constexpr size_t WS_SSQ = 0;
constexpr size_t WS_CS = 1 * MiB;
constexpr size_t WS_W = 6 * MiB;
constexpr size_t W_IN = 0, W_OUT = 6 * MiB, W_1 = 8 * MiB, W_2 = 16 * MiB, W_LAYER = 24 * MiB;
constexpr size_t WS_XB = 54 * MiB;
constexpr size_t WS_KV = 86 * MiB;
constexpr size_t WS_U = 102 * MiB;
constexpr size_t WS_MIX = 198 * MiB;
constexpr size_t WS_HFF = 102 * MiB;
constexpr size_t WS_END = 230 * MiB;
constexpr int LDS_BYTES = 147456;

#define LAS __attribute__((address_space(3)))
typedef unsigned short bf16;
typedef unsigned u32x4 __attribute__((ext_vector_type(4)));
typedef unsigned u32x2 __attribute__((ext_vector_type(2)));
typedef float f32x4 __attribute__((ext_vector_type(4)));
typedef float f32x2 __attribute__((ext_vector_type(2)));
typedef short bf16x8 __attribute__((ext_vector_type(8)));
#define LDS_WAIT() asm volatile("s_waitcnt lgkmcnt(0)" ::: "memory")
__device__ __forceinline__ unsigned f2bf(float f) { unsigned u = __builtin_bit_cast(unsigned, f); return (u + 0x7fffu + ((u >> 16) & 1u)) >> 16; }
__device__ __forceinline__ unsigned pk2(float lo, float hi) { return pg8::cvt_pk_bf16(lo, hi); }
__device__ __forceinline__ float bflo(unsigned w) { return __builtin_bit_cast(float, w << 16); }
__device__ __forceinline__ float bfhi(unsigned w) { return __builtin_bit_cast(float, w & 0xffff0000u); }
__device__ __forceinline__ float wave_sum(float v) {
#pragma unroll
    for (int o = 1; o < 64; o <<= 1) v += __shfl_xor(v, o);
    return v;
}
__device__ __forceinline__ float fast_sigmoid(float x) { return __builtin_amdgcn_rcpf(1.0f + __expf(-x)); }

struct Args {
    const float* x; const float* norm1_g; const float* w_in; const float* conv_w; const float* conv_b; const float* conv_ln_g; const float* conv_ln_b;
    const float* ret_norm_g; const float* w_out; const float* norm2_g; const float* w_ff1; const float* w_ff2; const float* final_g;
    float* out; unsigned char* ws; int ph_lo, ph_hi, coop, pad;
};

__device__ __forceinline__ void p0_transpose_item(const float* W, const float* gs, int K, int N, bf16* WT, LAS float* scr, int item, int lane) {
    const int nblk = N / 32, kb = item / nblk, nb = item % nblk, k0 = 64 * kb, n0 = 32 * nb;
#pragma unroll 8
    for (int i = 0; i < 32; ++i) { const int kk = 2 * i + (lane >> 5); const float g = gs ? gs[k0 + kk] : 1.0f; scr[kk * 33 + (lane & 31)] = W[(size_t)(k0 + kk) * N + n0 + (lane & 31)] * g; }
    LDS_WAIT(); asm volatile("" ::: "memory");
    const int c = lane & 7;
#pragma unroll
    for (int j = 0; j < 4; ++j) { const int n = (lane >> 3) + 8 * j; const LAS float* s = scr + (8 * c) * 33 + n;
        u32x4 o; o.x = pk2(s[0 * 33], s[1 * 33]); o.y = pk2(s[2 * 33], s[3 * 33]); o.z = pk2(s[4 * 33], s[5 * 33]); o.w = pk2(s[6 * 33], s[7 * 33]);
        *(u32x4*)(WT + (size_t)(n0 + n) * K + k0 + 8 * c) = o; }
    LDS_WAIT(); asm volatile("" ::: "memory");
}
__device__ __forceinline__ void p0_prologue(const Args& a, LAS unsigned char* lds, int tid, int lane, int wave) {
    LAS float* scr = (LAS float*)(lds + wave * 16384);
    const int gw = blockIdx.x * NWAVES + wave, NGW = gridDim.x * NWAVES;
    constexpr int I_IN = (DM / 64) * (INW / 32), I_O = (DM / 64) * (DM / 32), I_1 = (DM / 64) * (FF / 32), I_2 = (FF / 64) * (DM / 32), I_L = I_IN + I_O + I_1 + I_2;
    for (int it = gw; it < DEPTH * I_L; it += NGW) {
        const int l = it / I_L; int r = it % I_L; bf16* wl = (bf16*)(a.ws + WS_W + (size_t)l * W_LAYER);
        if (r < I_IN) { p0_transpose_item(a.w_in + (size_t)l * DM * INW, a.norm1_g + l * DM, DM, INW, (bf16*)((unsigned char*)wl + W_IN), scr, r, lane); continue; } r -= I_IN;
        if (r < I_O) { p0_transpose_item(a.w_out + (size_t)l * DM * DM, nullptr, DM, DM, (bf16*)((unsigned char*)wl + W_OUT), scr, r, lane); continue; } r -= I_O;
        if (r < I_1) { p0_transpose_item(a.w_ff1 + (size_t)l * DM * FF, a.norm2_g + l * DM, DM, FF, (bf16*)((unsigned char*)wl + W_1), scr, r, lane); continue; } r -= I_1;
        p0_transpose_item(a.w_ff2 + (size_t)l * FF * DM, nullptr, FF, DM, (bf16*)((unsigned char*)wl + W_2), scr, r, lane);
    }
    float* ssq = (float*)(a.ws + WS_SSQ); bf16* xb = (bf16*)(a.ws + WS_XB);
    for (int m = gw; m < M; m += NGW) {
        const f32x4* xr = (const f32x4*)(a.x + (size_t)m * DM) + lane; float s = 0.f; f32x4 v[4];
#pragma unroll
        for (int j = 0; j < 4; ++j) { v[j] = xr[64 * j]; s += (v[j].x * v[j].x + v[j].y * v[j].y) + (v[j].z * v[j].z + v[j].w * v[j].w); }
        s = wave_sum(s);
        u32x2* o8 = (u32x2*)(xb + (size_t)m * DM) + lane;
#pragma unroll
        for (int j = 0; j < 4; ++j) { u32x2 w; w.x = pk2(v[j].x, v[j].y); w.y = pk2(v[j].z, v[j].w); o8[64 * j] = w; }
        if (lane == 0) ssq[m] = s;
    }
    const int gt = blockIdx.x * NT + tid, NGT = gridDim.x * NT;
    for (int i = gt; i < 4 * M; i += NGT) ssq[M + i] = 0.f;
    f32x2* cs = (f32x2*)(a.ws + WS_CS);
    for (int i = gt; i < SEQ * 64; i += NGT) { const int pos = i >> 6, f = i & 63;
        const float invf = (float)exp2(-(double)f * (13.287712379549449 / 64.0));
        const float ang = (float)pos * invf;
        double rev = (double)ang * 0.15915494309189535; rev -= floor(rev);
        const float fr = (float)rev;
        cs[i] = (f32x2){__builtin_amdgcn_cosf(fr), __builtin_amdgcn_sinf(fr)}; }
}

__device__ __forceinline__ void conv_tile(const Args& a, int l, int tile, LAS unsigned char* lds, int tid, int lane, int wave) {
    LAS float* H = (LAS float*)lds;
    const bf16* u = (const bf16*)(a.ws + WS_U); bf16* mix = (bf16*)(a.ws + WS_MIX);
    const int b = tile >> 8, t0 = (tile & 255) * 32; const size_t rowbase = (size_t)b * SEQ;
    for (int e = tid; e < 62 * 64; e += NT) {
        const int r = e >> 6, ch = (e & 63) * 8, t = t0 - 30 + r;
        f32x4 h0 = {0.f, 0.f, 0.f, 0.f}, h1 = {0.f, 0.f, 0.f, 0.f};
        if (t >= 0) { const bf16* p = u + (rowbase + t) * INW + ch; const u32x4 av = *(const u32x4*)p, gv = *(const u32x4*)(p + CW);
            h0[0] = bflo(av.x) * fast_sigmoid(bflo(gv.x)); h0[1] = bfhi(av.x) * fast_sigmoid(bfhi(gv.x)); h0[2] = bflo(av.y) * fast_sigmoid(bflo(gv.y)); h0[3] = bfhi(av.y) * fast_sigmoid(bfhi(gv.y));
            h1[0] = bflo(av.z) * fast_sigmoid(bflo(gv.z)); h1[1] = bfhi(av.z) * fast_sigmoid(bfhi(gv.z)); h1[2] = bflo(av.w) * fast_sigmoid(bflo(gv.w)); h1[3] = bfhi(av.w) * fast_sigmoid(bfhi(gv.w)); }
        *(LAS f32x4*)(H + r * 512 + ch) = h0; *(LAS f32x4*)(H + r * 512 + ch + 4) = h1;
    }
    __syncthreads();
    const int cp = tid & 255, rg = tid >> 8;
    const float* cw = a.conv_w + (size_t)l * CK * CW + 2 * cp;
    f32x2 w[CK];
#pragma unroll
    for (int j = 0; j < CK; ++j) w[j] = *(const f32x2*)(cw + j * CW);
    const f32x2 bias = *(const f32x2*)(a.conv_b + l * CW + 2 * cp);
    f32x2 acc[16];
#pragma unroll
    for (int r = 0; r < 16; ++r) acc[r] = bias;
#pragma unroll
    for (int i = 0; i < 46; ++i) { const f32x2 h = *(const LAS f32x2*)(H + (rg * 16 + i) * 512 + 2 * cp);
#pragma unroll
        for (int r = 0; r < 16; ++r) { const int j = i - r; if (j >= 0 && j < CK) acc[r] += w[j] * h; }
        if ((i & 3) == 3) asm volatile("" ::: "memory"); }
    __syncthreads();
#pragma unroll
    for (int r = 0; r < 16; ++r) *(LAS f32x2*)(H + (rg * 16 + r) * 512 + 2 * cp) = acc[r];
    __syncthreads();
    const f32x4 g0 = *(const f32x4*)(a.conv_ln_g + l * CW + 8 * lane), g1 = *(const f32x4*)(a.conv_ln_g + l * CW + 8 * lane + 4);
    const f32x4 b0 = *(const f32x4*)(a.conv_ln_b + l * CW + 8 * lane), b1 = *(const f32x4*)(a.conv_ln_b + l * CW + 8 * lane + 4);
#pragma unroll
    for (int rr = 0; rr < 4; ++rr) { const int r = wave * 4 + rr;
        f32x4 v0 = *(const LAS f32x4*)(H + r * 512 + 8 * lane), v1 = *(const LAS f32x4*)(H + r * 512 + 8 * lane + 4);
        const float mu = wave_sum((v0[0] + v0[1]) + (v0[2] + v0[3]) + (v1[0] + v1[1]) + (v1[2] + v1[3])) * (1.0f / 512.0f);
        v0 = v0 - mu; v1 = v1 - mu;
        const float var = wave_sum((v0[0] * v0[0] + v0[1] * v0[1]) + (v0[2] * v0[2] + v0[3] * v0[3]) + (v1[0] * v1[0] + v1[1] * v1[1]) + (v1[2] * v1[2] + v1[3] * v1[3])) * (1.0f / 512.0f);
        const float rs = __builtin_amdgcn_rsqf(var + 1e-6f);
        v0 = v0 * rs * g0 + b0; v1 = v1 * rs * g1 + b1;
#pragma unroll
        for (int t = 0; t < 4; ++t) { v0[t] = v0[t] * fast_sigmoid(v0[t]); v1[t] = v1[t] * fast_sigmoid(v1[t]); }
        u32x4 o; o.x = pk2(v0[0], v0[1]); o.y = pk2(v0[2], v0[3]); o.z = pk2(v1[0], v1[1]); o.w = pk2(v1[2], v1[3]);
        *(u32x4*)(mix + (rowbase + t0 + r) * DM + 8 * lane) = o; }
    __syncthreads();
}

constexpr int R_QS = 0, R_KS = 17408, R_KT = 34816, R_VT = 53248, R_PS = 71680, R_ST = 80896, R_GP = 115712, R_RED = 116224;
constexpr int QS_LD = 136, KT_LD = 72, PS_LD = 72, ST_LD = 136;

__device__ __forceinline__ void ret_setup_gp(LAS unsigned char* lds, int h, int tid) {
    LAS float* gp = (LAS float*)(lds + R_GP);
    if (tid <= 64) { const float gamma = 1.0f - exp2f(-5.0f - (float)h); gp[tid] = exp2f((float)tid * log2f(gamma)); }
}
template <bool NEED_Q>
__device__ __forceinline__ void ret_load_chunk(const Args& a, LAS unsigned char* lds, size_t row0, int pos0, int h, int tid) {
    const bf16* u = (const bf16*)(a.ws + WS_U); const f32x4* cs = (const f32x4*)(a.ws + WS_CS);
    LAS bf16* Qs = (LAS bf16*)(lds + R_QS); LAS bf16* Ks = (LAS bf16*)(lds + R_KS); LAS bf16* KT = (LAS bf16*)(lds + R_KT); LAS bf16* VT = (LAS bf16*)(lds + R_VT);
    const LAS float* gp = (const LAS float*)(lds + R_GP);
    const int j = tid >> 3, c = tid & 7;
    const bf16* rowp = u + (row0 + j) * INW + h * HD;
    const f32x4* csp = cs + ((size_t)(pos0 + j) * 64 + 8 * c) / 2;
    const f32x4 cs0 = csp[0], cs1 = csp[1], cs2 = csp[2], cs3 = csp[3];
    float co[8] = {cs0[0], cs0[2], cs1[0], cs1[2], cs2[0], cs2[2], cs3[0], cs3[2]};
    float si[8] = {cs0[1], cs0[3], cs1[1], cs1[3], cs2[1], cs2[3], cs3[1], cs3[3]};
    {
        const u32x4 a1 = *(const u32x4*)(rowp + U_K + 8 * c), a2 = *(const u32x4*)(rowp + U_K + 64 + 8 * c);
        float x1[8] = {bflo(a1.x), bfhi(a1.x), bflo(a1.y), bfhi(a1.y), bflo(a1.z), bfhi(a1.z), bflo(a1.w), bfhi(a1.w)};
        float x2[8] = {bflo(a2.x), bfhi(a2.x), bflo(a2.y), bfhi(a2.y), bflo(a2.z), bfhi(a2.z), bflo(a2.w), bfhi(a2.w)};
        const float sc = 0.08838834764831845f, wk = gp[63 - j];
        float y1[8], y2[8];
#pragma unroll
        for (int t = 0; t < 8; ++t) { y1[t] = (x1[t] * co[t] - x2[t] * si[t]) * sc; y2[t] = (x1[t] * si[t] + x2[t] * co[t]) * sc; }
        if (NEED_Q) {
            u32x4 o1, o2; o1.x = pk2(y1[0], y1[1]); o1.y = pk2(y1[2], y1[3]); o1.z = pk2(y1[4], y1[5]); o1.w = pk2(y1[6], y1[7]);
            o2.x = pk2(y2[0], y2[1]); o2.y = pk2(y2[2], y2[3]); o2.z = pk2(y2[4], y2[5]); o2.w = pk2(y2[6], y2[7]);
            *(LAS u32x4*)(Ks + j * QS_LD + 8 * c) = o1; *(LAS u32x4*)(Ks + j * QS_LD + 64 + 8 * c) = o2; }
#pragma unroll
        for (int t = 0; t < 8; ++t) { KT[(8 * c + t) * KT_LD + j] = (bf16)f2bf(y1[t] * wk); KT[(64 + 8 * c + t) * KT_LD + j] = (bf16)f2bf(y2[t] * wk); }
    }
    if (NEED_Q) {
        const u32x4 a1 = *(const u32x4*)(rowp + U_Q + 8 * c), a2 = *(const u32x4*)(rowp + U_Q + 64 + 8 * c);
        float x1[8] = {bflo(a1.x), bfhi(a1.x), bflo(a1.y), bfhi(a1.y), bflo(a1.z), bfhi(a1.z), bflo(a1.w), bfhi(a1.w)};
        float x2[8] = {bflo(a2.x), bfhi(a2.x), bflo(a2.y), bfhi(a2.y), bflo(a2.z), bfhi(a2.z), bflo(a2.w), bfhi(a2.w)};
        float y1[8], y2[8];
#pragma unroll
        for (int t = 0; t < 8; ++t) { y1[t] = x1[t] * co[t] - x2[t] * si[t]; y2[t] = x1[t] * si[t] + x2[t] * co[t]; }
        u32x4 o1, o2; o1.x = pk2(y1[0], y1[1]); o1.y = pk2(y1[2], y1[3]); o1.z = pk2(y1[4], y1[5]); o1.w = pk2(y1[6], y1[7]);
        o2.x = pk2(y2[0], y2[1]); o2.y = pk2(y2[2], y2[3]); o2.z = pk2(y2[4], y2[5]); o2.w = pk2(y2[6], y2[7]);
        *(LAS u32x4*)(Qs + j * QS_LD + 8 * c) = o1; *(LAS u32x4*)(Qs + j * QS_LD + 64 + 8 * c) = o2;
    }
#pragma unroll
    for (int it = 0; it < 2; ++it) { const int idx = tid + NT * it, j2 = idx >> 4, c2 = idx & 15;
        const u32x4 vv = *(const u32x4*)(u + (row0 + j2) * INW + U_V + h * HD + 8 * c2);
        LAS bf16* vt = VT + (8 * c2) * KT_LD + j2;
        vt[0 * KT_LD] = (bf16)(vv.x & 0xffffu); vt[1 * KT_LD] = (bf16)(vv.x >> 16); vt[2 * KT_LD] = (bf16)(vv.y & 0xffffu); vt[3 * KT_LD] = (bf16)(vv.y >> 16);
        vt[4 * KT_LD] = (bf16)(vv.z & 0xffffu); vt[5 * KT_LD] = (bf16)(vv.z >> 16); vt[6 * KT_LD] = (bf16)(vv.w & 0xffffu); vt[7 * KT_LD] = (bf16)(vv.w >> 16); }
}
#define FRAG(base, ld, r, k) (*(const LAS bf16x8*)((base) + (r) * (ld) + (k)))
__device__ __forceinline__ void ret_kv_update(f32x4 (&S)[8], LAS unsigned char* lds, int wave, int fr, int fq) {
    const LAS bf16* KT = (const LAS bf16*)(lds + R_KT); const LAS bf16* VT = (const LAS bf16*)(lds + R_VT); const float g64 = ((const LAS float*)(lds + R_GP))[64];
    const bf16x8 a0 = FRAG(KT, KT_LD, 16 * wave + fr, 8 * fq), a1 = FRAG(KT, KT_LD, 16 * wave + fr, 32 + 8 * fq);
#pragma unroll
    for (int et = 0; et < 8; ++et) { S[et] = S[et] * g64;
        S[et] = __builtin_amdgcn_mfma_f32_16x16x32_bf16(a0, FRAG(VT, KT_LD, 16 * et + fr, 8 * fq), S[et], 0, 0, 0);
        S[et] = __builtin_amdgcn_mfma_f32_16x16x32_bf16(a1, FRAG(VT, KT_LD, 16 * et + fr, 32 + 8 * fq), S[et], 0, 0, 0); }
}
__device__ __forceinline__ void ret_kv_unit(const Args& a, int unit, LAS unsigned char* lds, int tid, int lane, int wave) {
    const int N = unit & 31, bh = unit >> 5, h = bh & 3, b = bh >> 2, fr = lane & 15, fq = lane >> 4;
    if (N == NSUP - 1) return;
    ret_setup_gp(lds, h, tid);
    f32x4 S[8];
#pragma unroll
    for (int et = 0; et < 8; ++et) S[et] = (f32x4){0.f, 0.f, 0.f, 0.f};
    const size_t row0 = (size_t)b * SEQ + (size_t)N * 256;
    for (int c = 0; c < 4; ++c) {
        __syncthreads();
        ret_load_chunk<false>(a, lds, row0 + c * 64, N * 256 + c * 64, h, tid);
        __syncthreads();
        ret_kv_update(S, lds, wave, fr, fq);
    }
    f32x4* kv = (f32x4*)(a.ws + WS_KV) + ((size_t)(unit * 8 + wave) * 8) * 64 + lane;
#pragma unroll
    for (int et = 0; et < 8; ++et) kv[et * 64] = S[et];
    __syncthreads();
}
__device__ __forceinline__ void ret_out_unit(const Args& a, int l, int unit, LAS unsigned char* lds, int tid, int lane, int wave) {
    const int N = unit & 31, bh = unit >> 5, h = bh & 3, b = bh >> 2, fr = lane & 15, fq = lane >> 4;
    const bf16* u = (const bf16*)(a.ws + WS_U); bf16* mix = (bf16*)(a.ws + WS_MIX);
    LAS bf16* Qs = (LAS bf16*)(lds + R_QS); LAS bf16* Ks = (LAS bf16*)(lds + R_KS); LAS bf16* VT = (LAS bf16*)(lds + R_VT);
    LAS bf16* Ps = (LAS bf16*)(lds + R_PS); LAS bf16* ST = (LAS bf16*)(lds + R_ST);
    LAS float* gp = (LAS float*)(lds + R_GP); LAS float* red = (LAS float*)(lds + R_RED);
    __syncthreads();
    ret_setup_gp(lds, h, tid);
    f32x4 S[8];
#pragma unroll
    for (int et = 0; et < 8; ++et) S[et] = (f32x4){0.f, 0.f, 0.f, 0.f};
    { const float gamma = 1.0f - exp2f(-5.0f - (float)h); const float G = exp2f(256.0f * log2f(gamma));
      const f32x4* kv = (const f32x4*)(a.ws + WS_KV) + ((size_t)((unit - N) * 8 + wave) * 8) * 64 + lane;
      for (int Mi = 0; Mi < N; ++Mi) {
#pragma unroll
          for (int et = 0; et < 8; ++et) S[et] = S[et] * G + kv[(size_t)Mi * 4096 + et * 64]; } }
    const size_t row0 = (size_t)b * SEQ + (size_t)N * 256;
    const int it = wave & 3, wh = wave >> 2, il = it * 16 + fr;
    const f32x4 ng[4] = { *(const f32x4*)(a.ret_norm_g + l * CW + h * HD + (4 * wh + 0) * 16 + 4 * fq), *(const f32x4*)(a.ret_norm_g + l * CW + h * HD + (4 * wh + 1) * 16 + 4 * fq),
                          *(const f32x4*)(a.ret_norm_g + l * CW + h * HD + (4 * wh + 2) * 16 + 4 * fq), *(const f32x4*)(a.ret_norm_g + l * CW + h * HD + (4 * wh + 3) * 16 + 4 * fq) };
    for (int c = 0; c < 4; ++c) {
        __syncthreads();
#pragma unroll
        for (int et = 0; et < 8; ++et) { u32x2 w; w.x = pk2(S[et][0], S[et][1]); w.y = pk2(S[et][2], S[et][3]); *(LAS u32x2*)(ST + (16 * et + fr) * ST_LD + 16 * wave + 4 * fq) = w; }
        ret_load_chunk<true>(a, lds, row0 + c * 64, N * 256 + c * 64, h, tid);
        __syncthreads();
#pragma unroll
        for (int jj2 = 0; jj2 < 2; ++jj2) { const int jt = 2 * wh + jj2; f32x4 sc = {0.f, 0.f, 0.f, 0.f};
#pragma unroll
            for (int ks = 0; ks < 4; ++ks) sc = __builtin_amdgcn_mfma_f32_16x16x32_bf16(FRAG(Ks, QS_LD, jt * 16 + fr, ks * 32 + 8 * fq), FRAG(Qs, QS_LD, it * 16 + fr, ks * 32 + 8 * fq), sc, 0, 0, 0);
            float p[4];
#pragma unroll
            for (int r = 0; r < 4; ++r) { const int jl = jt * 16 + 4 * fq + r; const int dd = il > jl ? il - jl : jl - il; p[r] = sc[r] * gp[dd]; }
            u32x2 w; w.x = pk2(p[0], p[1]); w.y = pk2(p[2], p[3]); *(LAS u32x2*)(Ps + il * PS_LD + jt * 16 + 4 * fq) = w; }
        __syncthreads();
        f32x4 o[4]; const float wq = gp[il + 1]; float qs = 0.f;
#pragma unroll
        for (int t = 0; t < 4; ++t) { const int et = 4 * wh + t; f32x4 acc = {0.f, 0.f, 0.f, 0.f};
#pragma unroll
            for (int ks = 0; ks < 4; ++ks) acc = __builtin_amdgcn_mfma_f32_16x16x32_bf16(FRAG(ST, ST_LD, et * 16 + fr, ks * 32 + 8 * fq), FRAG(Qs, QS_LD, it * 16 + fr, ks * 32 + 8 * fq), acc, 0, 0, 0);
            acc = acc * wq;
#pragma unroll
            for (int ks = 0; ks < 2; ++ks) acc = __builtin_amdgcn_mfma_f32_16x16x32_bf16(FRAG(VT, KT_LD, et * 16 + fr, ks * 32 + 8 * fq), FRAG(Ps, PS_LD, it * 16 + fr, ks * 32 + 8 * fq), acc, 0, 0, 0);
            o[t] = acc; qs += (acc[0] * acc[0] + acc[1] * acc[1]) + (acc[2] * acc[2] + acc[3] * acc[3]); }
        qs += __shfl_xor(qs, 16); qs += __shfl_xor(qs, 32);
        if (fq == 0) red[wh * 64 + il] = qs;
        if (c < 3) ret_kv_update(S, lds, wave, fr, fq);
        __syncthreads();
        const float rs = __builtin_amdgcn_rsqf((red[il] + red[64 + il]) * (1.0f / 128.0f) + 1e-6f);
        const size_t row = row0 + c * 64 + il;
#pragma unroll
        for (int t = 0; t < 4; ++t) { const int e0 = (4 * wh + t) * 16 + 4 * fq;
            const u32x2 gv = *(const u32x2*)(u + row * INW + U_G + h * HD + e0);
            const float g0 = bflo(gv.x), g1 = bfhi(gv.x), g2 = bflo(gv.y), g3 = bfhi(gv.y);
            const float y0 = o[t][0] * rs * ng[t][0] * (g0 * fast_sigmoid(g0)), y1 = o[t][1] * rs * ng[t][1] * (g1 * fast_sigmoid(g1));
            const float y2 = o[t][2] * rs * ng[t][2] * (g2 * fast_sigmoid(g2)), y3 = o[t][3] * rs * ng[t][3] * (g3 * fast_sigmoid(g3));
            u32x2 w; w.x = pk2(y0, y1); w.y = pk2(y2, y3); *(u32x2*)(mix + row * DM + CW + h * HD + e0) = w; }
    }
    __syncthreads();
}

__device__ __forceinline__ void final_norm(const Args& a, int lane, int wave) {
    const float* ssq = (const float*)(a.ws + WS_SSQ) + 4 * M;
    const int gw = blockIdx.x * NWAVES + wave, NGW = gridDim.x * NWAVES;
    f32x4 g[4];
#pragma unroll
    for (int j = 0; j < 4; ++j) g[j] = ((const f32x4*)a.final_g)[lane + 64 * j];
    for (int m = gw; m < M; m += NGW) { f32x4* xr = (f32x4*)(a.out + (size_t)m * DM) + lane; const float rs = __builtin_amdgcn_rsqf(ssq[m] * (1.0f / 1024.0f) + 1e-6f);
#pragma unroll
        for (int j = 0; j < 4; ++j) { const f32x4 v = xr[64 * j]; xr[64 * j] = v * rs * g[j]; } }
}

constexpr int N_PHASES = 2 + 6 * DEPTH;
#ifndef PH_MASK
#define PH_MASK 255
#endif
__global__ void __launch_bounds__(NT, 2) fwd_megakernel(Args a) {
    extern __shared__ __attribute__((aligned(16))) unsigned char lds_raw[];
    LAS unsigned char* lds = (LAS unsigned char*)lds_raw;
#define PHASE_TID() int tid = threadIdx.x; asm volatile("" : "+v"(tid)); const int lane = tid & 63, wave = __builtin_amdgcn_readfirstlane(tid >> 6); (void)lane; (void)wave
    const int lo = a.ph_lo, hi = a.ph_hi;
#define IN(k) (lo <= (k) && (k) < hi)
#define SEAM(k) do { if (IN(k) && IN((k) + 1)) { cg::this_grid().sync(); } } while (0)
    float* ssq = (float*)(a.ws + WS_SSQ);
    bf16* xb = (bf16*)(a.ws + WS_XB); bf16* U = (bf16*)(a.ws + WS_U); bf16* MIX = (bf16*)(a.ws + WS_MIX); bf16* HFF = (bf16*)(a.ws + WS_HFF);
    if (IN(0) && (PH_MASK & 1)) { PHASE_TID(); p0_prologue(a, lds, tid, lane, wave); }
    SEAM(0);
    for (int l = 0; l < DEPTH; ++l) {
        const int pb = 1 + 6 * l;
        const unsigned char* wl = a.ws + WS_W + (size_t)l * W_LAYER;
        if (IN(pb + 0) && (PH_MASK & 2)) {
            PHASE_TID(); pg8::Gemm g{xb, (const bf16*)(wl + W_IN), M, INW, DM}; pg8::StaticOrder S; S.init(M, INW, gridDim.x, blockIdx.x);
            pg8::EpiScale<0> E{U, INW, ssq + (2 * l) * M};
            pg8::gemm_phase<pg8::EpiScale<0>, pg8::StaticOrder, true, true>(lds, g, S, E, tid);
        }
        SEAM(pb + 0);
        if (IN(pb + 1) && (PH_MASK & 4)) {
            PHASE_TID();
            for (int it = blockIdx.x; it < 256; it += gridDim.x) ret_kv_unit(a, it, lds, tid, lane, wave);
            asm volatile("" ::: "memory");
            for (int it = blockIdx.x; it < 512; it += gridDim.x) conv_tile(a, l, it, lds, tid, lane, wave);
        }
        SEAM(pb + 1);
        if (IN(pb + 2) && (PH_MASK & 8)) {
            PHASE_TID();
            for (int it = blockIdx.x; it < 256; it += gridDim.x) ret_out_unit(a, l, it, lds, tid, lane, wave);
        }
        SEAM(pb + 2);
        if (IN(pb + 3) && (PH_MASK & 16)) {
            PHASE_TID(); pg8::Gemm g{MIX, (const bf16*)(wl + W_OUT), M, DM, DM}; pg8::StaticOrder S; S.init(M, DM, gridDim.x, blockIdx.x);
            pg8::EpiResid E{l == 0 ? a.x : a.out, a.out, xb, ssq + (2 * l + 1) * M};
            pg8::gemm_phase<pg8::EpiResid, pg8::StaticOrder, true, true>(lds, g, S, E, tid);
        }
        SEAM(pb + 3);
        if (IN(pb + 4) && (PH_MASK & 32)) {
            PHASE_TID(); pg8::Gemm g{xb, (const bf16*)(wl + W_1), M, FF, DM}; pg8::StaticOrder S; S.init(M, FF, gridDim.x, blockIdx.x);
            pg8::EpiScale<1> E{HFF, FF, ssq + (2 * l + 1) * M};
            pg8::gemm_phase<pg8::EpiScale<1>, pg8::StaticOrder, true, true>(lds, g, S, E, tid);
        }
        SEAM(pb + 4);
        if (IN(pb + 5) && (PH_MASK & 64)) {
            PHASE_TID(); pg8::Gemm g{HFF, (const bf16*)(wl + W_2), M, DM, FF}; pg8::StaticOrder S; S.init(M, DM, gridDim.x, blockIdx.x);
            pg8::EpiResid E{a.out, a.out, xb, ssq + (2 * l + 2) * M};
            pg8::gemm_phase<pg8::EpiResid, pg8::StaticOrder, true, true>(lds, g, S, E, tid);
        }
        SEAM(pb + 5);
    }
    if (IN(N_PHASES - 1) && (PH_MASK & 128)) { PHASE_TID(); final_norm(a, lane, wave); }
#undef IN
#undef SEAM
}

#ifndef MK_ONE_LAUNCH
#define MK_ONE_LAUNCH 1
#endif
extern "C" void kernel_launch(void* const* d_in, const int* in_sizes, int n_in, void* d_out, int out_size, void* d_ws, size_t ws_size, hipStream_t stream) {
    static int grid = 0;
    if (grid == 0) {
        if (n_in != 13 || in_sizes[0] != M * DM || out_size != M * DM || ws_size < WS_END) { fprintf(stderr, "kernel_launch: unexpected shapes (n_in %d in0 %d out %d ws %zu); nothing launched\n", n_in, n_in > 0 ? in_sizes[0] : -1, out_size, ws_size); grid = -1; return; }
        int dev = 0, cus = 0, per_cu = 0;
        if (hipGetDevice(&dev) != hipSuccess || hipDeviceGetAttribute(&cus, hipDeviceAttributeMultiprocessorCount, dev) != hipSuccess) { grid = -1; return; }
        if (hipFuncSetAttribute((const void*)fwd_megakernel, hipFuncAttributeMaxDynamicSharedMemorySize, LDS_BYTES) != hipSuccess) { fprintf(stderr, "kernel_launch: hipFuncSetAttribute failed\n"); grid = -1; return; }
        if (hipOccupancyMaxActiveBlocksPerMultiprocessor(&per_cu, (const void*)fwd_megakernel, NT, LDS_BYTES) != hipSuccess || per_cu < 1) { fprintf(stderr, "kernel_launch: occupancy query says %d blocks per CU\n", per_cu); per_cu = 1; }
        (void)hipGetLastError();
        grid = cus;
    }
    if (grid < 0) return;
    Args a{};
    a.x = (const float*)d_in[0]; a.norm1_g = (const float*)d_in[1]; a.w_in = (const float*)d_in[2]; a.conv_w = (const float*)d_in[3]; a.conv_b = (const float*)d_in[4];
    a.conv_ln_g = (const float*)d_in[5]; a.conv_ln_b = (const float*)d_in[6]; a.ret_norm_g = (const float*)d_in[7]; a.w_out = (const float*)d_in[8]; a.norm2_g = (const float*)d_in[9];
    a.w_ff1 = (const float*)d_in[10]; a.w_ff2 = (const float*)d_in[11]; a.final_g = (const float*)d_in[12];
    a.out = (float*)d_out; a.ws = (unsigned char*)d_ws;
#if MK_ONE_LAUNCH
    a.ph_lo = 0; a.ph_hi = N_PHASES; a.coop = 1;
    void* args[] = {&a};
    hipError_t e = hipLaunchCooperativeKernel((const void*)fwd_megakernel, dim3(grid), dim3(NT), args, LDS_BYTES, stream);
    if (e != hipSuccess) fprintf(stderr, "cooperative launch failed: %s (grid %d)\n", hipGetErrorString(e), grid);
#else
    for (int p = 0; p < N_PHASES; ++p) { a.ph_lo = p; a.ph_hi = p + 1; a.coop = 0;
        hipLaunchKernelGGL(fwd_megakernel, dim3(grid), dim3(NT), LDS_BYTES, stream, a); }
#endif
}
```

```cpp
#include <hip/hip_runtime.h>
#include <hip/hip_cooperative_groups.h>
#include <cstdio>
#include <cstdint>
namespace cg = cooperative_groups;
namespace pg8 {
#define PG8_LAS __attribute__((address_space(3)))
typedef unsigned short bf16_t;
typedef short bf16x8 __attribute__((ext_vector_type(8)));
typedef float f32x4 __attribute__((ext_vector_type(4)));
typedef unsigned u32x4 __attribute__((ext_vector_type(4)));
constexpr int BM = 256, BK = 64, HALF = 128, HTB = HALF * BK * 2  , STAGE_BYTES = 8 * HTB, NXCD = 8, WGM = 8;

__host__ __device__ __forceinline__ int lds_byte(int r, int c) { const int st = (r >> 4) * 2 + (c >> 5), rr = r & 15, cc = c & 31, ob = rr * 64 + cc * 2; return st * 1024 + (ob ^ (((ob >> 9) & 1) << 5)); }
__host__ __device__ __forceinline__ void stage_rc(int b, int& R, int& C) { const int st = b / 1024, sb = b % 1024, swz = sb ^ (((sb >> 9) & 1) << 5); R = (st >> 1) * 16 + swz / 64; C = (st & 1) * 32 + (swz % 64) / 2; }
__host__ __device__ __forceinline__ int perm32(int rho) { const int n = rho >> 4, i = rho & 15; return 8 * (i >> 2) + 4 * n + (i & 3); }

struct Unit { int pm, pn; };
struct Gemm { const bf16_t* A; const bf16_t* Bt; int M, N, K; };

struct StaticOrder {
    int nM, nN, nwg, G, c;
    __host__ __device__ void init(int M, int N, int G_, int c_) { nM = M / BM; nN = N / BM; nwg = nM * nN; G = G_; c = c_; }
    __host__ __device__ bool next(int i, Unit& u) const {
        const long L = (long)i * G + c; if (L >= nwg) return false;
        int wgid = (int)L; { const int q = nwg / NXCD, r = nwg % NXCD, xcd = wgid % NXCD, off = wgid / NXCD; wgid = (xcd < r ? xcd * (q + 1) : r * (q + 1) + (xcd - r) * q) + off; }
        const int nig = WGM * nN, gid = wgid / nig, fm = gid * WGM, gsz = (nM - fm) < WGM ? (nM - fm) : WGM;
        u.pm = fm + ((wgid % nig) % gsz); u.pn = (wgid % nig) / gsz; return true;
    }
    __device__ __forceinline__ void a_ready(const Unit&) const {}
    __device__ __forceinline__ void done(const Unit&) const {}
};
__device__ __forceinline__ unsigned cvt_pk_bf16(float lo, float hi) { unsigned r; asm volatile("v_cvt_pk_bf16_f32 %0, %1, %2" : "=v"(r) : "v"(lo), "v"(hi)); return r; }
typedef float f32x2 __attribute__((ext_vector_type(2)));
constexpr float RMS_EPS = 1e-6f;
template <int ACT> struct EpiScale {
    static constexpr bool PERM = true, AFTER_DRAIN = false;
    bf16_t* O; int ldc; const float* ssq;
    __device__ __forceinline__ void operator()(const f32x4 (&acc)[2][2][4][2], const Unit& u, int wr, int wc, int fr, int fq) const {
        const int row0 = u.pm * BM + wr * 64 + fr; const int col0 = u.pn * BM + wc * 32 + 8 * fq;
#pragma unroll
        for (int ai = 0; ai < 2; ++ai)
#pragma unroll
            for (int m = 0; m < 4; ++m) { const int row = row0 + ai * HALF + m * 16; const float rs = __builtin_amdgcn_rsqf(ssq[row] * (1.0f / 1024.0f) + RMS_EPS);
                bf16_t* rowp = O + (size_t)row * ldc + col0;
#pragma unroll
                for (int bj = 0; bj < 2; ++bj) { f32x4 v0 = acc[ai][bj][m][0] * rs, v1 = acc[ai][bj][m][1] * rs;
                    if (ACT == 1) {
#pragma unroll
                        for (int t = 0; t < 4; ++t) { float a = v0[t] > 0.f ? v0[t] : 0.f; v0[t] = a * a; float b = v1[t] > 0.f ? v1[t] : 0.f; v1[t] = b * b; } }
                    u32x4 w; w.x = cvt_pk_bf16(v0[0], v0[1]); w.y = cvt_pk_bf16(v0[2], v0[3]); w.z = cvt_pk_bf16(v1[0], v1[1]); w.w = cvt_pk_bf16(v1[2], v1[3]);
                    *(u32x4*)(rowp + bj * HALF) = w; } }
    }
};
struct EpiResid {
    static constexpr bool PERM = true, AFTER_DRAIN = false;
    const float* xin; float* xout; bf16_t* xb; float* ssq_out; float mul;
    __device__ __forceinline__ void operator()(const f32x4 (&acc)[2][2][4][2], const Unit& u, int wr, int wc, int fr, int fq) const {
        const int row0 = u.pm * BM + wr * 64 + fr; const int col0 = u.pn * BM + wc * 32 + 8 * fq;
#pragma unroll
        for (int ai = 0; ai < 2; ++ai)
#pragma unroll
            for (int m = 0; m < 4; ++m) { const int row = row0 + ai * HALF + m * 16; const size_t off = (size_t)row * 1024 + col0; float q = 0.f;
#pragma unroll
                for (int bj = 0; bj < 2; ++bj) { const f32x4 r0 = *(const f32x4*)(xin + off + bj * HALF), r1 = *(const f32x4*)(xin + off + bj * HALF + 4);
                    const f32x4 v0 = acc[ai][bj][m][0] * mul + r0, v1 = acc[ai][bj][m][1] * mul + r1;
                    *(f32x4*)(xout + off + bj * HALF) = v0; *(f32x4*)(xout + off + bj * HALF + 4) = v1;
                    u32x4 w; w.x = cvt_pk_bf16(v0[0], v0[1]); w.y = cvt_pk_bf16(v0[2], v0[3]); w.z = cvt_pk_bf16(v1[0], v1[1]); w.w = cvt_pk_bf16(v1[2], v1[3]);
                    *(u32x4*)(xb + off + bj * HALF) = w;
                    q += (v0[0] * v0[0] + v0[1] * v0[1]) + (v0[2] * v0[2] + v0[3] * v0[3]) + (v1[0] * v1[0] + v1[1] * v1[1]) + (v1[2] * v1[2] + v1[3] * v1[3]); }
                q += __shfl_xor(q, 16); q += __shfl_xor(q, 32);
                if (fq == 0) unsafeAtomicAdd(ssq_out + row, q); }
    }
};
template <class Epi, class Sched, bool ALIGN_EPI = false, bool SP2 = false>
__device__ __forceinline__ void gemm_phase(PG8_LAS unsigned char* lds, const Gemm g, const Sched& S, const Epi& E, const int tid) {
    const int wid = __builtin_amdgcn_readfirstlane(tid >> 6), lane = tid & 63, wr = wid >> 2, wc = wid & 3, fr = lane & 15, fq = lane >> 4;
    const int K = g.K, nt = K / BK;
    unsigned voffA[2], voffB[2];
#pragma unroll
    for (int i = 0; i < 2; ++i) { int R, C; stage_rc(tid * 16 + i * 8192, R, C); const int Rb = Epi::PERM ? ((R & ~31) + perm32(R & 31)) : R;
        voffA[i] = (unsigned)(R * K + C) * 2u; voffB[i] = (unsigned)(Rb * K + C) * 2u; }
    const size_t kstep = (size_t)(BK * 2);
    const size_t hstep = (size_t)HALF * K * 2;
    const size_t tstep = 2 * hstep;
    const unsigned ldsw = (unsigned)wid * 1024u;
    const int aoff = lds_byte(wr * 64 + fr, fq * 8), boff = lds_byte(wc * 32 + fr, fq * 8);
#define PG8_SA(b, h) (((b) * 2 + (h)) * HTB)
#define PG8_SB(b, h) ((4 + (b) * 2 + (h)) * HTB)
#define PG8_STAGE(bufoff, gbase, voff) do { _Pragma("unroll") for (int _i = 0; _i < 2; ++_i) \
        __builtin_amdgcn_global_load_lds((const unsigned*)((const char*)(gbase) + (voff)[_i]), (PG8_LAS unsigned*)(lds + (bufoff) + ldsw + _i * 8192), 16, 0, 0); } while (0)
#define PG8_LDA(dst, b, h) do { _Pragma("unroll") for (int m = 0; m < 4; ++m) _Pragma("unroll") for (int k = 0; k < 2; ++k) dst[m][k] = *(const PG8_LAS bf16x8*)(lds + PG8_SA(b, h) + aoff + m * 2048 + k * 1024); } while (0)
#define PG8_LDB(dst, b, h) do { _Pragma("unroll") for (int n = 0; n < 2; ++n) _Pragma("unroll") for (int k = 0; k < 2; ++k) dst[n][k] = *(const PG8_LAS bf16x8*)(lds + PG8_SB(b, h) + boff + n * 2048 + k * 1024); } while (0)
#define PG8_MMA(ai, bj, At, Bt) do { __builtin_amdgcn_s_setprio(1); _Pragma("unroll") for (int m = 0; m < 4; ++m) _Pragma("unroll") for (int n = 0; n < 2; ++n) _Pragma("unroll") for (int k = 0; k < 2; ++k) \
        acc[ai][bj][m][n] = __builtin_amdgcn_mfma_f32_16x16x32_bf16(Bt[n][k], At[m][k], acc[ai][bj][m][n], 0, 0, 0); __builtin_amdgcn_s_setprio(0); } while (0)
#define PG8_WAIT_V(n) asm volatile("s_waitcnt vmcnt(" #n ")" ::: "memory")
#define PG8_WAIT_L(n) asm volatile("s_waitcnt lgkmcnt(" #n ")" ::: "memory")
#define PG8_BAR __builtin_amdgcn_s_barrier()
#define PG8_SCHED __builtin_amdgcn_sched_barrier(0)
    Unit cur, nxt; int ui = 0;
    if (!S.next(0, cur)) return;
    f32x4 acc[2][2][4][2];
#pragma unroll
    for (int a = 0; a < 2; ++a)
#pragma unroll
        for (int b = 0; b < 2; ++b)
#pragma unroll
            for (int m = 0; m < 4; ++m)
#pragma unroll
                for (int n = 0; n < 2; ++n) acc[a][b][m][n] = (f32x4){0.f, 0.f, 0.f, 0.f};
    bf16x8 At[4][2], B0[2][2], B1[2][2];
    const char* cA = (const char*)g.A + (size_t)cur.pm * tstep; const char* cB = (const char*)g.Bt + (size_t)cur.pn * tstep;
    S.a_ready(cur);
    if constexpr (SP2) {
        PG8_STAGE(PG8_SB(0, 0), cB, voffB); PG8_STAGE(PG8_SB(0, 1), cB + hstep, voffB); PG8_STAGE(PG8_SA(0, 0), cA, voffA); PG8_STAGE(PG8_SA(0, 1), cA + hstep, voffA);
        if (wr == 1) PG8_BAR;
        PG8_WAIT_V(2); PG8_BAR;
        PG8_STAGE(PG8_SB(1, 0), cB + kstep, voffB); PG8_STAGE(PG8_SA(1, 0), cA + kstep, voffA); PG8_STAGE(PG8_SB(1, 1), cB + hstep + kstep, voffB);
        PG8_WAIT_V(6); PG8_BAR;
    } else {
        PG8_STAGE(PG8_SB(0, 0), cB, voffB); PG8_STAGE(PG8_SA(0, 0), cA, voffA); PG8_STAGE(PG8_SB(0, 1), cB + hstep, voffB); PG8_STAGE(PG8_SA(0, 1), cA + hstep, voffA);
        if (wr == 1) PG8_BAR;
        PG8_WAIT_V(4); PG8_BAR;
        PG8_STAGE(PG8_SB(1, 0), cB + kstep, voffB); PG8_STAGE(PG8_SA(1, 0), cA + kstep, voffA); PG8_STAGE(PG8_SB(1, 1), cB + hstep + kstep, voffB);
        PG8_WAIT_V(6); PG8_BAR;
    }
    for (;;) {
        const bool has_next = S.next(ui + 1, nxt);
        const char* nA = has_next ? (const char*)g.A + (size_t)nxt.pm * tstep : cA; const char* nB = has_next ? (const char*)g.Bt + (size_t)nxt.pn * tstep : cB;
        for (int t = 0; t < nt; t += 2) {
            const bool last = (t == nt - 2);
            const char* a1 = cA + (size_t)(t + 1) * kstep;
            const char* a2 = last ? nA : cA + (size_t)(t + 2) * kstep; const char* b2 = last ? nB : cB + (size_t)(t + 2) * kstep;
            const char* a3 = a2 + kstep; const char* b3 = b2 + kstep;
            if (last && has_next) S.a_ready(nxt);
            if constexpr (SP2) {
            PG8_LDB(B0, 0, 0); PG8_LDB(B1, 0, 1); PG8_SCHED; PG8_LDA(At, 0, 0); PG8_STAGE(PG8_SA(1, 1), a1 + hstep, voffA);
            PG8_WAIT_V(8); PG8_WAIT_L(0); PG8_BAR; PG8_MMA(0, 0, At, B0); PG8_MMA(0, 1, At, B1); PG8_BAR; PG8_SCHED;
            PG8_LDA(At, 0, 1); PG8_STAGE(PG8_SB(0, 0), b2, voffB); PG8_STAGE(PG8_SB(0, 1), b2 + hstep, voffB); PG8_STAGE(PG8_SA(0, 0), a2, voffA);
            PG8_WAIT_V(8); PG8_WAIT_L(0); PG8_BAR; PG8_MMA(1, 0, At, B0); PG8_MMA(1, 1, At, B1); PG8_BAR; PG8_SCHED;
            PG8_LDB(B0, 1, 0); PG8_LDB(B1, 1, 1); PG8_SCHED; PG8_LDA(At, 1, 0); PG8_STAGE(PG8_SA(0, 1), a2 + hstep, voffA);
            PG8_WAIT_V(8); PG8_WAIT_L(0); PG8_BAR; PG8_MMA(0, 0, At, B0); PG8_MMA(0, 1, At, B1); PG8_BAR; PG8_SCHED;
            PG8_LDA(At, 1, 1); PG8_STAGE(PG8_SB(1, 0), b3, voffB); PG8_STAGE(PG8_SB(1, 1), b3 + hstep, voffB); PG8_STAGE(PG8_SA(1, 0), a3, voffA);
            PG8_WAIT_V(8); PG8_WAIT_L(0); PG8_BAR; PG8_MMA(1, 0, At, B0); PG8_MMA(1, 1, At, B1); PG8_BAR; PG8_SCHED;
            } else {
            PG8_LDB(B0, 0, 0); PG8_SCHED; PG8_LDA(At, 0, 0); PG8_STAGE(PG8_SA(1, 1), a1 + hstep, voffA);
            PG8_WAIT_L(8); PG8_BAR; PG8_WAIT_L(0); PG8_MMA(0, 0, At, B0); PG8_BAR; PG8_SCHED;
            PG8_LDB(B1, 0, 1); PG8_STAGE(PG8_SB(0, 0), b2, voffB);
            PG8_BAR; PG8_WAIT_L(0); PG8_MMA(0, 1, At, B1); PG8_BAR;
            PG8_LDA(At, 0, 1); PG8_STAGE(PG8_SA(0, 0), a2, voffA);
            PG8_BAR; PG8_WAIT_L(0); PG8_MMA(1, 0, At, B0); PG8_BAR; PG8_SCHED;
            PG8_STAGE(PG8_SB(0, 1), b2 + hstep, voffB);
            PG8_WAIT_V(6); PG8_BAR; PG8_MMA(1, 1, At, B1); PG8_BAR;
            PG8_LDB(B0, 1, 0); PG8_SCHED; PG8_LDA(At, 1, 0); PG8_STAGE(PG8_SA(0, 1), a2 + hstep, voffA);
            PG8_WAIT_L(8); PG8_BAR; PG8_WAIT_L(0); PG8_MMA(0, 0, At, B0); PG8_BAR; PG8_SCHED;
            PG8_LDB(B1, 1, 1); PG8_STAGE(PG8_SB(1, 0), b3, voffB);
            PG8_BAR; PG8_WAIT_L(0); PG8_MMA(0, 1, At, B1); PG8_BAR;
            PG8_LDA(At, 1, 1); PG8_STAGE(PG8_SA(1, 0), a3, voffA);
            PG8_BAR; PG8_WAIT_L(0); PG8_MMA(1, 0, At, B0); PG8_BAR; PG8_SCHED;
            PG8_STAGE(PG8_SB(1, 1), b3 + hstep, voffB);
            PG8_WAIT_V(6); PG8_BAR; PG8_MMA(1, 1, At, B1); PG8_BAR;
            }
        }
        if constexpr (ALIGN_EPI) { if (wr == 0) PG8_BAR; }
        if constexpr (!Epi::AFTER_DRAIN) { E(acc, cur, wr, wc, fr, fq); S.done(cur); }
        if (!has_next) break;
#pragma unroll
        for (int a = 0; a < 2; ++a)
#pragma unroll
            for (int b = 0; b < 2; ++b)
#pragma unroll
                for (int m = 0; m < 4; ++m)
#pragma unroll
                    for (int n = 0; n < 2; ++n) acc[a][b][m][n] = (f32x4){0.f, 0.f, 0.f, 0.f};
        cur = nxt; cA = nA; cB = nB; ++ui;
        if constexpr (ALIGN_EPI) { if (wr == 1) PG8_BAR; }
    }
    PG8_WAIT_V(0);
    if constexpr (!ALIGN_EPI) { if (wr == 0) PG8_BAR; }
    PG8_BAR;
    if constexpr (Epi::AFTER_DRAIN) { E.fused(acc, cur, wr, wc, fr, fq, lds, wid, lane); S.done(cur); }
#undef PG8_SA
#undef PG8_SB
#undef PG8_STAGE
#undef PG8_LDA
#undef PG8_LDB
#undef PG8_MMA
#undef PG8_WAIT_V
#undef PG8_WAIT_L
#undef PG8_BAR
#undef PG8_SCHED
}
}
constexpr int NWAVES = 8, NT = 512;
constexpr int BATCH = 2, SEQ = 8192, DM = 1024, DEPTH = 2, FF = 4096, INW = 3072, CW = 512, NH = 4, HD = 128, CK = 31;
constexpr int M = BATCH * SEQ;
constexpr int U_Q = 1024, U_K = 1536, U_V = 2048, U_G = 2560;
constexpr int NSUP = SEQ / 256;
constexpr size_t MiB = 1u << 20;
constexpr size_t WS_SSQ = 0;
constexpr size_t WS_BAR = 512 * 1024;
constexpr size_t WS_CS = 1 * MiB;
constexpr size_t WS_W = 6 * MiB;
constexpr size_t W_IN = 0, W_OUT = 6 * MiB, W_1 = 8 * MiB, W_2 = 16 * MiB, W_LAYER = 24 * MiB;
constexpr size_t WS_XB = 54 * MiB;
constexpr size_t WS_KV = 86 * MiB;
constexpr size_t WS_U = 102 * MiB;
constexpr size_t WS_MIX = 198 * MiB;
constexpr size_t WS_HFF = 102 * MiB;
constexpr size_t WS_END = 230 * MiB;
constexpr int LDS_BYTES = 147456;

#define LAS __attribute__((address_space(3)))
typedef unsigned short bf16;
typedef unsigned u32x4 __attribute__((ext_vector_type(4)));
typedef unsigned u32x2 __attribute__((ext_vector_type(2)));
typedef float f32x4 __attribute__((ext_vector_type(4)));
typedef float f32x2 __attribute__((ext_vector_type(2)));
typedef short bf16x8 __attribute__((ext_vector_type(8)));
#define LDS_WAIT() asm volatile("s_waitcnt lgkmcnt(0)" ::: "memory")
__device__ __forceinline__ unsigned f2bf(float f) { unsigned u = __builtin_bit_cast(unsigned, f); return (u + 0x7fffu + ((u >> 16) & 1u)) >> 16; }
__device__ __forceinline__ unsigned pk2(float lo, float hi) { return pg8::cvt_pk_bf16(lo, hi); }
__device__ __forceinline__ float bflo(unsigned w) { return __builtin_bit_cast(float, w << 16); }
__device__ __forceinline__ float bfhi(unsigned w) { return __builtin_bit_cast(float, w & 0xffff0000u); }
__device__ __forceinline__ float wave_sum(float v) {
#pragma unroll
    for (int o = 1; o < 64; o <<= 1) v += __shfl_xor(v, o);
    return v;
}
__device__ __forceinline__ float fast_sigmoid(float x) { return __builtin_amdgcn_rcpf(1.0f + __expf(-x)); }

struct Args {
    const float* x; const float* norm1_g; const float* w_in; const float* conv_w; const float* conv_b; const float* conv_ln_g; const float* conv_ln_b;
    const float* ret_norm_g; const float* w_out; const float* norm2_g; const float* w_ff1; const float* w_ff2; const float* final_g;
    float* out; unsigned char* ws; int ph_lo, ph_hi, coop, pad;
};

__device__ __forceinline__ void p0_transpose_item(const float* W, const float* gs, int K, int N, bf16* WT, LAS float* scr, int item, int lane) {
    const int nblk = N / 32, kb = item / nblk, nb = item % nblk, k0 = 64 * kb, n0 = 32 * nb;
#pragma unroll 8
    for (int i = 0; i < 32; ++i) { const int kk = 2 * i + (lane >> 5); const float g = gs ? gs[k0 + kk] : 1.0f; scr[kk * 33 + (lane & 31)] = W[(size_t)(k0 + kk) * N + n0 + (lane & 31)] * g; }
    LDS_WAIT(); asm volatile("" ::: "memory");
    const int c = lane & 7;
#pragma unroll
    for (int j = 0; j < 4; ++j) { const int n = (lane >> 3) + 8 * j; const LAS float* s = scr + (8 * c) * 33 + n;
        u32x4 o; o.x = pk2(s[0 * 33], s[1 * 33]); o.y = pk2(s[2 * 33], s[3 * 33]); o.z = pk2(s[4 * 33], s[5 * 33]); o.w = pk2(s[6 * 33], s[7 * 33]);
        *(u32x4*)(WT + (size_t)(n0 + n) * K + k0 + 8 * c) = o; }
    LDS_WAIT(); asm volatile("" ::: "memory");
}
__device__ __forceinline__ void p0_prologue(const Args& a, LAS unsigned char* lds, int tid, int lane, int wave) {
    LAS float* scr = (LAS float*)(lds + wave * 16384);
    const int gw = blockIdx.x * NWAVES + wave, NGW = gridDim.x * NWAVES;
    constexpr int I_IN = (DM / 64) * (INW / 32), I_O = (DM / 64) * (DM / 32), I_1 = (DM / 64) * (FF / 32), I_2 = (FF / 64) * (DM / 32), I_L = I_IN + I_O + I_1 + I_2;
    for (int it = gw; it < DEPTH * I_L; it += NGW) {
        const int l = it / I_L; int r = it % I_L; bf16* wl = (bf16*)(a.ws + WS_W + (size_t)l * W_LAYER);
        if (r < I_IN) { p0_transpose_item(a.w_in + (size_t)l * DM * INW, a.norm1_g + l * DM, DM, INW, (bf16*)((unsigned char*)wl + W_IN), scr, r, lane); continue; } r -= I_IN;
        if (r < I_O) { p0_transpose_item(a.w_out + (size_t)l * DM * DM, nullptr, DM, DM, (bf16*)((unsigned char*)wl + W_OUT), scr, r, lane); continue; } r -= I_O;
        if (r < I_1) { p0_transpose_item(a.w_ff1 + (size_t)l * DM * FF, a.norm2_g + l * DM, DM, FF, (bf16*)((unsigned char*)wl + W_1), scr, r, lane); continue; } r -= I_1;
        p0_transpose_item(a.w_ff2 + (size_t)l * FF * DM, nullptr, FF, DM, (bf16*)((unsigned char*)wl + W_2), scr, r, lane);
    }
    float* ssq = (float*)(a.ws + WS_SSQ); bf16* xb = (bf16*)(a.ws + WS_XB);
    for (int m = gw; m < M; m += NGW) {
        const f32x4* xr = (const f32x4*)(a.x + (size_t)m * DM) + lane; float s = 0.f; f32x4 v[4];
#pragma unroll
        for (int j = 0; j < 4; ++j) { v[j] = xr[64 * j]; s += (v[j].x * v[j].x + v[j].y * v[j].y) + (v[j].z * v[j].z + v[j].w * v[j].w); }
        s = wave_sum(s);
        u32x2* o8 = (u32x2*)(xb + (size_t)m * DM) + lane;
#pragma unroll
        for (int j = 0; j < 4; ++j) { u32x2 w; w.x = pk2(v[j].x, v[j].y); w.y = pk2(v[j].z, v[j].w); o8[64 * j] = w; }
        if (lane == 0) ssq[m] = s;
    }
    const int gt = blockIdx.x * NT + tid, NGT = gridDim.x * NT;
    for (int i = gt; i < 4 * M; i += NGT) ssq[M + i] = 0.f;
    f32x2* cs = (f32x2*)(a.ws + WS_CS);
    for (int i = gt; i < SEQ * 64; i += NGT) { const int pos = i >> 6, f = i & 63;
        const float invf = (float)exp2(-(double)f * (13.287712379549449 / 64.0));
        const float ang = (float)pos * invf;
        double rev = (double)ang * 0.15915494309189535; rev -= floor(rev);
        const float fr = (float)rev;
        cs[i] = (f32x2){__builtin_amdgcn_cosf(fr), __builtin_amdgcn_sinf(fr)}; }
}

__device__ __forceinline__ void conv_tile(const Args& a, int l, int tile, LAS unsigned char* lds, int tid, int lane, int wave) {
    LAS float* H = (LAS float*)lds;
    const bf16* u = (const bf16*)(a.ws + WS_U); bf16* mix = (bf16*)(a.ws + WS_MIX);
    const int b = tile >> 8, t0 = (tile & 255) * 32; const size_t rowbase = (size_t)b * SEQ;
    for (int e = tid; e < 62 * 64; e += NT) {
        const int r = e >> 6, ch = (e & 63) * 8, t = t0 - 30 + r;
        f32x4 h0 = {0.f, 0.f, 0.f, 0.f}, h1 = {0.f, 0.f, 0.f, 0.f};
        if (t >= 0) { const bf16* p = u + (rowbase + t) * INW + ch; const u32x4 av = *(const u32x4*)p, gv = *(const u32x4*)(p + CW);
            h0[0] = bflo(av.x) * fast_sigmoid(bflo(gv.x)); h0[1] = bfhi(av.x) * fast_sigmoid(bfhi(gv.x)); h0[2] = bflo(av.y) * fast_sigmoid(bflo(gv.y)); h0[3] = bfhi(av.y) * fast_sigmoid(bfhi(gv.y));
            h1[0] = bflo(av.z) * fast_sigmoid(bflo(gv.z)); h1[1] = bfhi(av.z) * fast_sigmoid(bfhi(gv.z)); h1[2] = bflo(av.w) * fast_sigmoid(bflo(gv.w)); h1[3] = bfhi(av.w) * fast_sigmoid(bfhi(gv.w)); }
        *(LAS f32x4*)(H + r * 512 + ch) = h0; *(LAS f32x4*)(H + r * 512 + ch + 4) = h1;
    }
    __syncthreads();
    const int cp = tid & 255, rg = tid >> 8;
    const float* cw = a.conv_w + (size_t)l * CK * CW + 2 * cp;
    f32x2 w[CK];
#pragma unroll
    for (int j = 0; j < CK; ++j) w[j] = *(const f32x2*)(cw + j * CW);
    const f32x2 bias = *(const f32x2*)(a.conv_b + l * CW + 2 * cp);
    f32x2 acc[16];
#pragma unroll
    for (int r = 0; r < 16; ++r) acc[r] = bias;
#pragma unroll
    for (int i = 0; i < 46; ++i) { const f32x2 h = *(const LAS f32x2*)(H + (rg * 16 + i) * 512 + 2 * cp);
#pragma unroll
        for (int r = 0; r < 16; ++r) { const int j = i - r; if (j >= 0 && j < CK) acc[r] += w[j] * h; }
        if ((i & 3) == 3) asm volatile("" ::: "memory"); }
    __syncthreads();
#pragma unroll
    for (int r = 0; r < 16; ++r) *(LAS f32x2*)(H + (rg * 16 + r) * 512 + 2 * cp) = acc[r];
    __syncthreads();
    const f32x4 g0 = *(const f32x4*)(a.conv_ln_g + l * CW + 8 * lane), g1 = *(const f32x4*)(a.conv_ln_g + l * CW + 8 * lane + 4);
    const f32x4 b0 = *(const f32x4*)(a.conv_ln_b + l * CW + 8 * lane), b1 = *(const f32x4*)(a.conv_ln_b + l * CW + 8 * lane + 4);
#pragma unroll
    for (int rr = 0; rr < 4; ++rr) { const int r = wave * 4 + rr;
        f32x4 v0 = *(const LAS f32x4*)(H + r * 512 + 8 * lane), v1 = *(const LAS f32x4*)(H + r * 512 + 8 * lane + 4);
        const float mu = wave_sum((v0[0] + v0[1]) + (v0[2] + v0[3]) + (v1[0] + v1[1]) + (v1[2] + v1[3])) * (1.0f / 512.0f);
        v0 = v0 - mu; v1 = v1 - mu;
        const float var = wave_sum((v0[0] * v0[0] + v0[1] * v0[1]) + (v0[2] * v0[2] + v0[3] * v0[3]) + (v1[0] * v1[0] + v1[1] * v1[1]) + (v1[2] * v1[2] + v1[3] * v1[3])) * (1.0f / 512.0f);
        const float rs = __builtin_amdgcn_rsqf(var + 1e-6f);
        v0 = v0 * rs * g0 + b0; v1 = v1 * rs * g1 + b1;
#pragma unroll
        for (int t = 0; t < 4; ++t) { v0[t] = v0[t] * fast_sigmoid(v0[t]); v1[t] = v1[t] * fast_sigmoid(v1[t]); }
        u32x4 o; o.x = pk2(v0[0], v0[1]); o.y = pk2(v0[2], v0[3]); o.z = pk2(v1[0], v1[1]); o.w = pk2(v1[2], v1[3]);
        *(u32x4*)(mix + (rowbase + t0 + r) * DM + 8 * lane) = o; }
    __syncthreads();
}

constexpr int R_QS = 0, R_KS = 17408, R_KT = 34816, R_VT = 53248, R_PS = 71680, R_ST = 80896, R_GP = 115712, R_RED = 116224;
constexpr int QS_LD = 136, KT_LD = 72, PS_LD = 72, ST_LD = 136;

__device__ __forceinline__ void ret_setup_gp(LAS unsigned char* lds, int h, int tid) {
    LAS float* gp = (LAS float*)(lds + R_GP);
    if (tid <= 64) { const float gamma = 1.0f - exp2f(-5.0f - (float)h); gp[tid] = exp2f((float)tid * log2f(gamma)); }
}
template <bool NEED_Q>
__device__ __forceinline__ void ret_load_chunk(const Args& a, LAS unsigned char* lds, size_t row0, int pos0, int h, int tid) {
    const bf16* u = (const bf16*)(a.ws + WS_U); const f32x4* cs = (const f32x4*)(a.ws + WS_CS);
    LAS bf16* Qs = (LAS bf16*)(lds + R_QS); LAS bf16* Ks = (LAS bf16*)(lds + R_KS); LAS bf16* KT = (LAS bf16*)(lds + R_KT); LAS bf16* VT = (LAS bf16*)(lds + R_VT);
    const LAS float* gp = (const LAS float*)(lds + R_GP);
    const int j = tid >> 3, c = tid & 7;
    const bf16* rowp = u + (row0 + j) * INW + h * HD;
    const f32x4* csp = cs + ((size_t)(pos0 + j) * 64 + 8 * c) / 2;
    const f32x4 cs0 = csp[0], cs1 = csp[1], cs2 = csp[2], cs3 = csp[3];
    float co[8] = {cs0[0], cs0[2], cs1[0], cs1[2], cs2[0], cs2[2], cs3[0], cs3[2]};
    float si[8] = {cs0[1], cs0[3], cs1[1], cs1[3], cs2[1], cs2[3], cs3[1], cs3[3]};
    {
        const u32x4 a1 = *(const u32x4*)(rowp + U_K + 8 * c), a2 = *(const u32x4*)(rowp + U_K + 64 + 8 * c);
        float x1[8] = {bflo(a1.x), bfhi(a1.x), bflo(a1.y), bfhi(a1.y), bflo(a1.z), bfhi(a1.z), bflo(a1.w), bfhi(a1.w)};
        float x2[8] = {bflo(a2.x), bfhi(a2.x), bflo(a2.y), bfhi(a2.y), bflo(a2.z), bfhi(a2.z), bflo(a2.w), bfhi(a2.w)};
        const float sc = 0.08838834764831845f, wk = gp[63 - j];
        float y1[8], y2[8];
#pragma unroll
        for (int t = 0; t < 8; ++t) { y1[t] = (x1[t] * co[t] - x2[t] * si[t]) * sc; y2[t] = (x1[t] * si[t] + x2[t] * co[t]) * sc; }
        if (NEED_Q) {
            u32x4 o1, o2; o1.x = pk2(y1[0], y1[1]); o1.y = pk2(y1[2], y1[3]); o1.z = pk2(y1[4], y1[5]); o1.w = pk2(y1[6], y1[7]);
            o2.x = pk2(y2[0], y2[1]); o2.y = pk2(y2[2], y2[3]); o2.z = pk2(y2[4], y2[5]); o2.w = pk2(y2[6], y2[7]);
            *(LAS u32x4*)(Ks + j * QS_LD + 8 * c) = o1; *(LAS u32x4*)(Ks + j * QS_LD + 64 + 8 * c) = o2; }
#pragma unroll
        for (int t = 0; t < 8; ++t) { KT[(8 * c + t) * KT_LD + j] = (bf16)f2bf(y1[t] * wk); KT[(64 + 8 * c + t) * KT_LD + j] = (bf16)f2bf(y2[t] * wk); }
    }
    if (NEED_Q) {
        const u32x4 a1 = *(const u32x4*)(rowp + U_Q + 8 * c), a2 = *(const u32x4*)(rowp + U_Q + 64 + 8 * c);
        float x1[8] = {bflo(a1.x), bfhi(a1.x), bflo(a1.y), bfhi(a1.y), bflo(a1.z), bfhi(a1.z), bflo(a1.w), bfhi(a1.w)};
        float x2[8] = {bflo(a2.x), bfhi(a2.x), bflo(a2.y), bfhi(a2.y), bflo(a2.z), bfhi(a2.z), bflo(a2.w), bfhi(a2.w)};
        float y1[8], y2[8];
#pragma unroll
        for (int t = 0; t < 8; ++t) { y1[t] = x1[t] * co[t] - x2[t] * si[t]; y2[t] = x1[t] * si[t] + x2[t] * co[t]; }
        u32x4 o1, o2; o1.x = pk2(y1[0], y1[1]); o1.y = pk2(y1[2], y1[3]); o1.z = pk2(y1[4], y1[5]); o1.w = pk2(y1[6], y1[7]);
        o2.x = pk2(y2[0], y2[1]); o2.y = pk2(y2[2], y2[3]); o2.z = pk2(y2[4], y2[5]); o2.w = pk2(y2[6], y2[7]);
        *(LAS u32x4*)(Qs + j * QS_LD + 8 * c) = o1; *(LAS u32x4*)(Qs + j * QS_LD + 64 + 8 * c) = o2;
    }
#pragma unroll
    for (int it = 0; it < 2; ++it) { const int idx = tid + NT * it, j2 = idx >> 4, c2 = idx & 15;
        const u32x4 vv = *(const u32x4*)(u + (row0 + j2) * INW + U_V + h * HD + 8 * c2);
        LAS bf16* vt = VT + (8 * c2) * KT_LD + j2;
        vt[0 * KT_LD] = (bf16)(vv.x & 0xffffu); vt[1 * KT_LD] = (bf16)(vv.x >> 16); vt[2 * KT_LD] = (bf16)(vv.y & 0xffffu); vt[3 * KT_LD] = (bf16)(vv.y >> 16);
        vt[4 * KT_LD] = (bf16)(vv.z & 0xffffu); vt[5 * KT_LD] = (bf16)(vv.z >> 16); vt[6 * KT_LD] = (bf16)(vv.w & 0xffffu); vt[7 * KT_LD] = (bf16)(vv.w >> 16); }
}
#define FRAG(base, ld, r, k) (*(const LAS bf16x8*)((base) + (r) * (ld) + (k)))
__device__ __forceinline__ void ret_kv_update(f32x4 (&S)[8], LAS unsigned char* lds, int wave, int fr, int fq) {
    const LAS bf16* KT = (const LAS bf16*)(lds + R_KT); const LAS bf16* VT = (const LAS bf16*)(lds + R_VT); const float g64 = ((const LAS float*)(lds + R_GP))[64];
    const bf16x8 a0 = FRAG(KT, KT_LD, 16 * wave + fr, 8 * fq), a1 = FRAG(KT, KT_LD, 16 * wave + fr, 32 + 8 * fq);
#pragma unroll
    for (int et = 0; et < 8; ++et) { S[et] = S[et] * g64;
        S[et] = __builtin_amdgcn_mfma_f32_16x16x32_bf16(a0, FRAG(VT, KT_LD, 16 * et + fr, 8 * fq), S[et], 0, 0, 0);
        S[et] = __builtin_amdgcn_mfma_f32_16x16x32_bf16(a1, FRAG(VT, KT_LD, 16 * et + fr, 32 + 8 * fq), S[et], 0, 0, 0); }
}
__device__ __forceinline__ void ret_kv_unit(const Args& a, int unit, LAS unsigned char* lds, int tid, int lane, int wave) {
    const int N = unit & 31, bh = unit >> 5, h = bh & 3, b = bh >> 2, fr = lane & 15, fq = lane >> 4;
    if (N == NSUP - 1) return;
    ret_setup_gp(lds, h, tid);
    f32x4 S[8];
#pragma unroll
    for (int et = 0; et < 8; ++et) S[et] = (f32x4){0.f, 0.f, 0.f, 0.f};
    const size_t row0 = (size_t)b * SEQ + (size_t)N * 256;
    for (int c = 0; c < 4; ++c) {
        __syncthreads();
        ret_load_chunk<false>(a, lds, row0 + c * 64, N * 256 + c * 64, h, tid);
        __syncthreads();
        ret_kv_update(S, lds, wave, fr, fq);
    }
    f32x4* kv = (f32x4*)(a.ws + WS_KV) + ((size_t)(unit * 8 + wave) * 8) * 64 + lane;
#pragma unroll
    for (int et = 0; et < 8; ++et) kv[et * 64] = S[et];
    __syncthreads();
}
__device__ __forceinline__ void ret_out_unit(const Args& a, int l, int unit, LAS unsigned char* lds, int tid, int lane, int wave) {
    const int N = unit & 31, bh = unit >> 5, h = bh & 3, b = bh >> 2, fr = lane & 15, fq = lane >> 4;
    const bf16* u = (const bf16*)(a.ws + WS_U); bf16* mix = (bf16*)(a.ws + WS_MIX);
    LAS bf16* Qs = (LAS bf16*)(lds + R_QS); LAS bf16* Ks = (LAS bf16*)(lds + R_KS); LAS bf16* VT = (LAS bf16*)(lds + R_VT);
    LAS bf16* Ps = (LAS bf16*)(lds + R_PS); LAS bf16* ST = (LAS bf16*)(lds + R_ST);
    LAS float* gp = (LAS float*)(lds + R_GP); LAS float* red = (LAS float*)(lds + R_RED);
    __syncthreads();
    ret_setup_gp(lds, h, tid);
    f32x4 S[8];
#pragma unroll
    for (int et = 0; et < 8; ++et) S[et] = (f32x4){0.f, 0.f, 0.f, 0.f};
    { const float gamma = 1.0f - exp2f(-5.0f - (float)h); const float G = exp2f(256.0f * log2f(gamma));
      const f32x4* kv = (const f32x4*)(a.ws + WS_KV) + ((size_t)((unit - N) * 8 + wave) * 8) * 64 + lane;
      for (int Mi = 0; Mi < N; ++Mi) {
#pragma unroll
          for (int et = 0; et < 8; ++et) S[et] = S[et] * G + kv[(size_t)Mi * 4096 + et * 64]; } }
    const size_t row0 = (size_t)b * SEQ + (size_t)N * 256;
    const int it = wave & 3, wh = wave >> 2, il = it * 16 + fr;
    const f32x4 ng[4] = { *(const f32x4*)(a.ret_norm_g + l * CW + h * HD + (4 * wh + 0) * 16 + 4 * fq), *(const f32x4*)(a.ret_norm_g + l * CW + h * HD + (4 * wh + 1) * 16 + 4 * fq),
                          *(const f32x4*)(a.ret_norm_g + l * CW + h * HD + (4 * wh + 2) * 16 + 4 * fq), *(const f32x4*)(a.ret_norm_g + l * CW + h * HD + (4 * wh + 3) * 16 + 4 * fq) };
    for (int c = 0; c < 4; ++c) {
        __syncthreads();
#pragma unroll
        for (int et = 0; et < 8; ++et) { u32x2 w; w.x = pk2(S[et][0], S[et][1]); w.y = pk2(S[et][2], S[et][3]); *(LAS u32x2*)(ST + (16 * et + fr) * ST_LD + 16 * wave + 4 * fq) = w; }
        ret_load_chunk<true>(a, lds, row0 + c * 64, N * 256 + c * 64, h, tid);
        __syncthreads();
#pragma unroll
        for (int jj2 = 0; jj2 < 2; ++jj2) { const int jt = 2 * wh + jj2; f32x4 sc = {0.f, 0.f, 0.f, 0.f};
#pragma unroll
            for (int ks = 0; ks < 4; ++ks) sc = __builtin_amdgcn_mfma_f32_16x16x32_bf16(FRAG(Ks, QS_LD, jt * 16 + fr, ks * 32 + 8 * fq), FRAG(Qs, QS_LD, it * 16 + fr, ks * 32 + 8 * fq), sc, 0, 0, 0);
            float p[4];
#pragma unroll
            for (int r = 0; r < 4; ++r) { const int jl = jt * 16 + 4 * fq + r; const int dd = il > jl ? il - jl : jl - il; p[r] = sc[r] * gp[dd]; }
            u32x2 w; w.x = pk2(p[0], p[1]); w.y = pk2(p[2], p[3]); *(LAS u32x2*)(Ps + il * PS_LD + jt * 16 + 4 * fq) = w; }
        __syncthreads();
        f32x4 o[4]; const float wq = gp[il + 1]; float qs = 0.f;
#pragma unroll
        for (int t = 0; t < 4; ++t) { const int et = 4 * wh + t; f32x4 acc = {0.f, 0.f, 0.f, 0.f};
#pragma unroll
            for (int ks = 0; ks < 4; ++ks) acc = __builtin_amdgcn_mfma_f32_16x16x32_bf16(FRAG(ST, ST_LD, et * 16 + fr, ks * 32 + 8 * fq), FRAG(Qs, QS_LD, it * 16 + fr, ks * 32 + 8 * fq), acc, 0, 0, 0);
            acc = acc * wq;
#pragma unroll
            for (int ks = 0; ks < 2; ++ks) acc = __builtin_amdgcn_mfma_f32_16x16x32_bf16(FRAG(VT, KT_LD, et * 16 + fr, ks * 32 + 8 * fq), FRAG(Ps, PS_LD, it * 16 + fr, ks * 32 + 8 * fq), acc, 0, 0, 0);
            o[t] = acc; qs += (acc[0] * acc[0] + acc[1] * acc[1]) + (acc[2] * acc[2] + acc[3] * acc[3]); }
        qs += __shfl_xor(qs, 16); qs += __shfl_xor(qs, 32);
        if (fq == 0) red[wh * 64 + il] = qs;
        if (c < 3) ret_kv_update(S, lds, wave, fr, fq);
        __syncthreads();
        const float rs = __builtin_amdgcn_rsqf((red[il] + red[64 + il]) * (1.0f / 128.0f) + 1e-6f);
        const size_t row = row0 + c * 64 + il;
#pragma unroll
        for (int t = 0; t < 4; ++t) { const int e0 = (4 * wh + t) * 16 + 4 * fq;
            const u32x2 gv = *(const u32x2*)(u + row * INW + U_G + h * HD + e0);
            const float g0 = bflo(gv.x), g1 = bfhi(gv.x), g2 = bflo(gv.y), g3 = bfhi(gv.y);
            const float y0 = o[t][0] * rs * ng[t][0] * (g0 * fast_sigmoid(g0)), y1 = o[t][1] * rs * ng[t][1] * (g1 * fast_sigmoid(g1));
            const float y2 = o[t][2] * rs * ng[t][2] * (g2 * fast_sigmoid(g2)), y3 = o[t][3] * rs * ng[t][3] * (g3 * fast_sigmoid(g3));
            u32x2 w; w.x = pk2(y0, y1); w.y = pk2(y2, y3); *(u32x2*)(mix + row * DM + CW + h * HD + e0) = w; }
    }
    __syncthreads();
}

__device__ __forceinline__ void final_norm(const Args& a, int lane, int wave) {
    const float* ssq = (const float*)(a.ws + WS_SSQ) + 4 * M;
    const int gw = blockIdx.x * NWAVES + wave, NGW = gridDim.x * NWAVES;
    f32x4 g[4];
#pragma unroll
    for (int j = 0; j < 4; ++j) g[j] = ((const f32x4*)a.final_g)[lane + 64 * j];
    for (int m = gw; m < M; m += NGW) { f32x4* xr = (f32x4*)(a.out + (size_t)m * DM) + lane; const float rs = __builtin_amdgcn_rsqf(ssq[m] * (1.0f / 1024.0f) + 1e-6f);
#pragma unroll
        for (int j = 0; j < 4; ++j) { const f32x4 v = xr[64 * j]; xr[64 * j] = v * rs * g[j]; } }
}

#define RLX_AGENT __ATOMIC_RELAXED, __HIP_MEMORY_SCOPE_AGENT
#define XB_TMO      128
#define XB_XCNT(j)  (256  + 64 * (j))
#define XB_XSUB(j)  (1280 + 64 * (j))
#define XB_XGEN(j)  (2304 + 64 * (j))
#define XB_TOP      3328
#define XB_TOPGEN   3392
#define XCD_BAR_WORDS 3456
#define XB_SPIN_CAP (1u << 18)

__device__ __forceinline__ unsigned xb_ld(unsigned* p)              { return __hip_atomic_load(p, __ATOMIC_RELAXED, __HIP_MEMORY_SCOPE_AGENT); }
__device__ __forceinline__ unsigned xb_add(unsigned* p, unsigned v) { return __hip_atomic_fetch_add(p, v, __ATOMIC_RELAXED, __HIP_MEMORY_SCOPE_AGENT); }
__device__ __forceinline__ unsigned xb_xcc_id() { return (unsigned)__builtin_amdgcn_s_getreg((3 << 11) | 20) & 0xFu; }
#define XB_SPIN(cond, bar) do { unsigned _sp = 0; while (cond) { __builtin_amdgcn_s_sleep(1); \
    if ((++_sp & 255u) == 0u) { if (xb_ld(&(bar)[XB_TMO])) break; if (_sp > XB_SPIN_CAP) { atomicAdd(&(bar)[XB_TMO], 1u); break; } } } } while (0)

struct XcdBarrier {
    unsigned* bar; unsigned x;
    volatile LAS unsigned* st;
};

__device__ __forceinline__ XcdBarrier xcd_barrier_post(unsigned* bar, volatile LAS unsigned* st) {
    XcdBarrier b; b.bar = bar; b.x = xb_xcc_id(); b.st = st;
    if (threadIdx.x == 0) (void)xb_add(&bar[XB_XCNT(b.x)], 1u);
    return b;
}
__device__ __forceinline__ void xcd_barrier_complete(unsigned* bar, unsigned x, unsigned& nloc, unsigned& nx) {
    const unsigned G = gridDim.x * gridDim.y * gridDim.z;
    unsigned sum, cnt, mine, sp = 0u;
    for (;;) {
        sum = 0u; cnt = 0u; mine = 0u;
#pragma unroll
        for (unsigned j = 0; j < 16; ++j) { const unsigned c = xb_ld(&bar[XB_XCNT(j)]); sum += c; cnt += (c > 0u) ? 1u : 0u; mine = (j == x) ? c : mine; }
        if (sum == G) break;
        __builtin_amdgcn_s_sleep(1);
        if ((++sp & 255u) == 0u) { if (xb_ld(&bar[XB_TMO])) break; if (sp > XB_SPIN_CAP) { atomicAdd(&bar[XB_TMO], 1u); break; } }
    }
    nloc = mine > 0u ? mine : 1u; nx = cnt > 0u ? cnt : 1u;
}

__device__ __forceinline__ void xcd_barrier(const XcdBarrier& b) {
    asm volatile("s_waitcnt vmcnt(0)" ::: "memory");
    __syncthreads();
    if (threadIdx.x == 0) {
        unsigned* bar = b.bar;
        __builtin_amdgcn_s_waitcnt(0);
        unsigned nloc = b.st[0], nx = b.st[1];
        if (nloc == 0u) { xcd_barrier_complete(bar, b.x, nloc, nx); b.st[0] = nloc; b.st[1] = nx; }
        const unsigned old = xb_add(&bar[XB_XSUB(b.x)], 1u);
        const unsigned gen = old / nloc;
        if (old + 1u == (gen + 1u) * nloc) {
            __builtin_amdgcn_fence(__ATOMIC_RELEASE, "agent");
            asm volatile("s_waitcnt vmcnt(0)" ::: "memory");
            const unsigned og = xb_add(&bar[XB_TOP], 1u);
            const unsigned tg = og / nx;
            if (og + 1u == (tg + 1u) * nx) xb_add(&bar[XB_TOPGEN], 1u);
            else XB_SPIN(xb_ld(&bar[XB_TOPGEN]) == tg, bar);
            __builtin_amdgcn_fence(__ATOMIC_ACQUIRE, "agent");
            xb_add(&bar[XB_XGEN(b.x)], 1u);
            asm volatile("s_waitcnt vmcnt(0)" ::: "memory");
        } else {
            XB_SPIN(xb_ld(&bar[XB_XGEN(b.x)]) == gen, bar);
            __builtin_amdgcn_fence(__ATOMIC_ACQUIRE, "agent");
            asm volatile("s_waitcnt vmcnt(0)" ::: "memory");
        }
    }
    __syncthreads();
}

constexpr int N_PHASES = 2 + 6 * DEPTH;
#ifndef DUP_MASK
#define DUP_MASK 0
#endif
#ifndef PH_MASK
#define PH_MASK 255
#endif
__global__ void __launch_bounds__(NT, 2) fwd_megakernel(Args a) {
    extern __shared__ __attribute__((aligned(16))) unsigned char lds_raw[];
    LAS unsigned char* lds = (LAS unsigned char*)lds_raw;
#define PHASE_TID() int tid = threadIdx.x; asm volatile("" : "+v"(tid)); const int lane = tid & 63, wave = __builtin_amdgcn_readfirstlane(tid >> 6); (void)lane; (void)wave
    const int lo = a.ph_lo, hi = a.ph_hi;
    volatile LAS unsigned* bst = (volatile LAS unsigned*)(lds + LDS_BYTES - 256);
    if (threadIdx.x < 2) bst[threadIdx.x] = 0u;
    __syncthreads();
    XcdBarrier bar; bar.bar = (unsigned*)(a.ws + WS_BAR); bar.x = 0; bar.st = bst;
    if (a.coop) bar = xcd_barrier_post((unsigned*)(a.ws + WS_BAR), bst);
#define IN(k) (lo <= (k) && (k) < hi)
#define SEAM(k) do { if (IN(k) && IN((k) + 1)) { if ((k) == 0) cg::this_grid().sync(); else xcd_barrier(bar); } } while (0)
    float* ssq = (float*)(a.ws + WS_SSQ);
    bf16* xb = (bf16*)(a.ws + WS_XB); bf16* U = (bf16*)(a.ws + WS_U); bf16* MIX = (bf16*)(a.ws + WS_MIX); bf16* HFF = (bf16*)(a.ws + WS_HFF);
    if (IN(0) && (PH_MASK & 1)) for (int rep = 0; rep < ((DUP_MASK & 1) ? 2 : 1); ++rep) { PHASE_TID(); p0_prologue(a, lds, tid, lane, wave); }
    SEAM(0);
    for (int l = 0; l < DEPTH; ++l) {
        const int pb = 1 + 6 * l;
        const unsigned char* wl = a.ws + WS_W + (size_t)l * W_LAYER;
        if (IN(pb + 0) && (PH_MASK & 2)) for (int rep = 0; rep < ((DUP_MASK & 2) ? 2 : 1); ++rep) {
            PHASE_TID(); pg8::Gemm g{xb, (const bf16*)(wl + W_IN), M, INW, DM}; pg8::StaticOrder S; S.init(M, INW, gridDim.x, blockIdx.x);
            pg8::EpiScale<0> E{U, INW, ssq + (2 * l) * M};
            pg8::gemm_phase<pg8::EpiScale<0>, pg8::StaticOrder, true, true>(lds, g, S, E, tid);
        }
        SEAM(pb + 0);
        if (IN(pb + 1) && (PH_MASK & 4)) for (int rep = 0; rep < ((DUP_MASK & 4) ? 2 : 1); ++rep) {
            PHASE_TID();
            for (int it = blockIdx.x; it < 256; it += gridDim.x) ret_kv_unit(a, it, lds, tid, lane, wave);
            asm volatile("" ::: "memory");
            for (int it = blockIdx.x; it < 512; it += gridDim.x) conv_tile(a, l, it, lds, tid, lane, wave);
        }
        SEAM(pb + 1);
        if (IN(pb + 2) && (PH_MASK & 8)) for (int rep = 0; rep < ((DUP_MASK & 8) ? 2 : 1); ++rep) {
            PHASE_TID();
            for (int it = blockIdx.x; it < 256; it += gridDim.x) ret_out_unit(a, l, it, lds, tid, lane, wave);
        }
        SEAM(pb + 2);
        if (IN(pb + 3) && (PH_MASK & 16)) for (int rep = ((DUP_MASK & 16) ? 0 : 1); rep < 2; ++rep) {
            PHASE_TID(); pg8::Gemm g{MIX, (const bf16*)(wl + W_OUT), M, DM, DM}; pg8::StaticOrder S; S.init(M, DM, gridDim.x, blockIdx.x);
            pg8::EpiResid E{(l == 0 && rep == 1) ? a.x : a.out, a.out, xb, rep ? ssq + (2 * l + 1) * M : ssq, rep ? 1.0f : 0.0f};
            pg8::gemm_phase<pg8::EpiResid, pg8::StaticOrder, true, true>(lds, g, S, E, tid);
        }
        SEAM(pb + 3);
        if (IN(pb + 4) && (PH_MASK & 32)) for (int rep = 0; rep < ((DUP_MASK & 32) ? 2 : 1); ++rep) {
            PHASE_TID(); pg8::Gemm g{xb, (const bf16*)(wl + W_1), M, FF, DM}; pg8::StaticOrder S; S.init(M, FF, gridDim.x, blockIdx.x);
            pg8::EpiScale<1> E{HFF, FF, ssq + (2 * l + 1) * M};
            pg8::gemm_phase<pg8::EpiScale<1>, pg8::StaticOrder, true, true>(lds, g, S, E, tid);
        }
        SEAM(pb + 4);
        if (IN(pb + 5) && (PH_MASK & 64)) for (int rep = ((DUP_MASK & 64) ? 0 : 1); rep < 2; ++rep) {
            PHASE_TID(); pg8::Gemm g{HFF, (const bf16*)(wl + W_2), M, DM, FF}; pg8::StaticOrder S; S.init(M, DM, gridDim.x, blockIdx.x);
            pg8::EpiResid E{a.out, a.out, xb, rep ? ssq + (2 * l + 2) * M : ssq, rep ? 1.0f : 0.0f};
            pg8::gemm_phase<pg8::EpiResid, pg8::StaticOrder, true, true>(lds, g, S, E, tid);
        }
        SEAM(pb + 5);
    }
    if (IN(N_PHASES - 1) && (PH_MASK & 128)) { PHASE_TID(); final_norm(a, lane, wave); }
#undef IN
#undef SEAM
}

#ifndef MK_ONE_LAUNCH
#define MK_ONE_LAUNCH 1
#endif
extern "C" void kernel_launch(void* const* d_in, const int* in_sizes, int n_in, void* d_out, int out_size, void* d_ws, size_t ws_size, hipStream_t stream) {
    static int grid = 0;
    if (grid == 0) {
        if (n_in != 13 || in_sizes[0] != M * DM || out_size != M * DM || ws_size < WS_END) { fprintf(stderr, "kernel_launch: unexpected shapes (n_in %d in0 %d out %d ws %zu); nothing launched\n", n_in, n_in > 0 ? in_sizes[0] : -1, out_size, ws_size); grid = -1; return; }
        int dev = 0, cus = 0, per_cu = 0;
        if (hipGetDevice(&dev) != hipSuccess || hipDeviceGetAttribute(&cus, hipDeviceAttributeMultiprocessorCount, dev) != hipSuccess) { grid = -1; return; }
        if (hipFuncSetAttribute((const void*)fwd_megakernel, hipFuncAttributeMaxDynamicSharedMemorySize, LDS_BYTES) != hipSuccess) { fprintf(stderr, "kernel_launch: hipFuncSetAttribute failed\n"); grid = -1; return; }
        if (hipOccupancyMaxActiveBlocksPerMultiprocessor(&per_cu, (const void*)fwd_megakernel, NT, LDS_BYTES) != hipSuccess || per_cu < 1) { fprintf(stderr, "kernel_launch: occupancy query says %d blocks per CU\n", per_cu); per_cu = 1; }
        (void)hipGetLastError();
        grid = cus;
    }
    if (grid < 0) return;
    Args a{};
    a.x = (const float*)d_in[0]; a.norm1_g = (const float*)d_in[1]; a.w_in = (const float*)d_in[2]; a.conv_w = (const float*)d_in[3]; a.conv_b = (const float*)d_in[4];
    a.conv_ln_g = (const float*)d_in[5]; a.conv_ln_b = (const float*)d_in[6]; a.ret_norm_g = (const float*)d_in[7]; a.w_out = (const float*)d_in[8]; a.norm2_g = (const float*)d_in[9];
    a.w_ff1 = (const float*)d_in[10]; a.w_ff2 = (const float*)d_in[11]; a.final_g = (const float*)d_in[12];
    a.out = (float*)d_out; a.ws = (unsigned char*)d_ws;
#if MK_ONE_LAUNCH
    if (hipMemsetAsync((char*)d_ws + WS_BAR, 0, XCD_BAR_WORDS * 4, stream) != hipSuccess) { fprintf(stderr, "kernel_launch: memset failed\n"); return; }
    a.ph_lo = 0; a.ph_hi = N_PHASES; a.coop = 1;
    void* args[] = {&a};
    hipError_t e = hipLaunchCooperativeKernel((const void*)fwd_megakernel, dim3(grid), dim3(NT), args, LDS_BYTES, stream);
    if (e != hipSuccess) fprintf(stderr, "cooperative launch failed: %s (grid %d)\n", hipGetErrorString(e), grid);
#else
    for (int p = 0; p < N_PHASES; ++p) { a.ph_lo = p; a.ph_hi = p + 1; a.coop = 0;
        hipLaunchKernelGGL(fwd_megakernel, dim3(grid), dim3(NT), LDS_BYTES, stream, a); }
#endif
}
```

```cpp
#include <hip/hip_runtime.h>
#include <hip/hip_cooperative_groups.h>
#include <cstdio>
#include <cstdint>
namespace cg = cooperative_groups;
namespace pg8 {
#define PG8_LAS __attribute__((address_space(3)))
typedef unsigned short bf16_t;
typedef short bf16x8 __attribute__((ext_vector_type(8)));
typedef float f32x4 __attribute__((ext_vector_type(4)));
typedef unsigned u32x4 __attribute__((ext_vector_type(4)));
constexpr int BM = 256, BK = 64, HALF = 128, HTB = HALF * BK * 2  , STAGE_BYTES = 8 * HTB, NXCD = 8, WGM = 8;

__host__ __device__ __forceinline__ int lds_byte(int r, int c) { const int st = (r >> 4) * 2 + (c >> 5), rr = r & 15, cc = c & 31, ob = rr * 64 + cc * 2; return st * 1024 + (ob ^ (((ob >> 9) & 1) << 5)); }
__host__ __device__ __forceinline__ void stage_rc(int b, int& R, int& C) { const int st = b / 1024, sb = b % 1024, swz = sb ^ (((sb >> 9) & 1) << 5); R = (st >> 1) * 16 + swz / 64; C = (st & 1) * 32 + (swz % 64) / 2; }
__host__ __device__ __forceinline__ int perm32(int rho) { const int n = rho >> 4, i = rho & 15; return 8 * (i >> 2) + 4 * n + (i & 3); }

struct Unit { int pm, pn; };
struct Gemm { const bf16_t* A; const bf16_t* Bt; int M, N, K; };

struct StaticOrder {
    int nM, nN, nwg, G, c;
    __host__ __device__ void init(int M, int N, int G_, int c_) { nM = M / BM; nN = N / BM; nwg = nM * nN; G = G_; c = c_; }
    __host__ __device__ bool next(int i, Unit& u) const {
        const long L = (long)i * G + c; if (L >= nwg) return false;
        int wgid = (int)L; { const int q = nwg / NXCD, r = nwg % NXCD, xcd = wgid % NXCD, off = wgid / NXCD; wgid = (xcd < r ? xcd * (q + 1) : r * (q + 1) + (xcd - r) * q) + off; }
        const int nig = WGM * nN, gid = wgid / nig, fm = gid * WGM, gsz = (nM - fm) < WGM ? (nM - fm) : WGM;
        u.pm = fm + ((wgid % nig) % gsz); u.pn = (wgid % nig) / gsz; return true;
    }
    __device__ __forceinline__ void a_ready(const Unit&) const {}
    __device__ __forceinline__ void done(const Unit&) const {}
};
__device__ __forceinline__ unsigned cvt_pk_bf16(float lo, float hi) { unsigned r; asm volatile("v_cvt_pk_bf16_f32 %0, %1, %2" : "=v"(r) : "v"(lo), "v"(hi)); return r; }
typedef float f32x2 __attribute__((ext_vector_type(2)));
constexpr float RMS_EPS = 1e-6f;
template <int ACT> struct EpiScale {
    static constexpr bool PERM = true, AFTER_DRAIN = false;
    bf16_t* O; int ldc; const float* ssq;
    __device__ __forceinline__ void operator()(const f32x4 (&acc)[2][2][4][2], const Unit& u, int wr, int wc, int fr, int fq) const {
        const int row0 = u.pm * BM + wr * 64 + fr; const int col0 = u.pn * BM + wc * 32 + 8 * fq;
#pragma unroll
        for (int ai = 0; ai < 2; ++ai)
#pragma unroll
            for (int m = 0; m < 4; ++m) { const int row = row0 + ai * HALF + m * 16; const float rs = __builtin_amdgcn_rsqf(ssq[row] * (1.0f / 1024.0f) + RMS_EPS);
                bf16_t* rowp = O + (size_t)row * ldc + col0;
#pragma unroll
                for (int bj = 0; bj < 2; ++bj) { f32x4 v0 = acc[ai][bj][m][0] * rs, v1 = acc[ai][bj][m][1] * rs;
                    if (ACT == 1) {
#pragma unroll
                        for (int t = 0; t < 4; ++t) { float a = v0[t] > 0.f ? v0[t] : 0.f; v0[t] = a * a; float b = v1[t] > 0.f ? v1[t] : 0.f; v1[t] = b * b; } }
                    u32x4 w; w.x = cvt_pk_bf16(v0[0], v0[1]); w.y = cvt_pk_bf16(v0[2], v0[3]); w.z = cvt_pk_bf16(v1[0], v1[1]); w.w = cvt_pk_bf16(v1[2], v1[3]);
                    *(u32x4*)(rowp + bj * HALF) = w; } }
    }
};
struct EpiResid {
    static constexpr bool PERM = true, AFTER_DRAIN = false;
    const float* xin; float* xout; bf16_t* xb; float* ssq_out; float mul;
    __device__ __forceinline__ void operator()(const f32x4 (&acc)[2][2][4][2], const Unit& u, int wr, int wc, int fr, int fq) const {
        const int row0 = u.pm * BM + wr * 64 + fr; const int col0 = u.pn * BM + wc * 32 + 8 * fq;
#pragma unroll
        for (int ai = 0; ai < 2; ++ai)
#pragma unroll
            for (int m = 0; m < 4; ++m) { const int row = row0 + ai * HALF + m * 16; const size_t off = (size_t)row * 1024 + col0; float q = 0.f;
#pragma unroll
                for (int bj = 0; bj < 2; ++bj) { const f32x4 r0 = *(const f32x4*)(xin + off + bj * HALF), r1 = *(const f32x4*)(xin + off + bj * HALF + 4);
                    const f32x4 v0 = acc[ai][bj][m][0] * mul + r0, v1 = acc[ai][bj][m][1] * mul + r1;
                    *(f32x4*)(xout + off + bj * HALF) = v0; *(f32x4*)(xout + off + bj * HALF + 4) = v1;
                    u32x4 w; w.x = cvt_pk_bf16(v0[0], v0[1]); w.y = cvt_pk_bf16(v0[2], v0[3]); w.z = cvt_pk_bf16(v1[0], v1[1]); w.w = cvt_pk_bf16(v1[2], v1[3]);
                    *(u32x4*)(xb + off + bj * HALF) = w;
                    q += (v0[0] * v0[0] + v0[1] * v0[1]) + (v0[2] * v0[2] + v0[3] * v0[3]) + (v1[0] * v1[0] + v1[1] * v1[1]) + (v1[2] * v1[2] + v1[3] * v1[3]); }
                q += __shfl_xor(q, 16); q += __shfl_xor(q, 32);
                if (fq == 0) unsafeAtomicAdd(ssq_out + row, q); }
    }
};
template <class Epi, class Sched, bool ALIGN_EPI = false, bool SP2 = false>
__device__ __forceinline__ void gemm_phase(PG8_LAS unsigned char* lds, const Gemm g, const Sched& S, const Epi& E, const int tid) {
    const int wid = __builtin_amdgcn_readfirstlane(tid >> 6), lane = tid & 63, wr = wid >> 2, wc = wid & 3, fr = lane & 15, fq = lane >> 4;
    const int K = g.K, nt = K / BK;
    unsigned voffA[2], voffB[2];
#pragma unroll
    for (int i = 0; i < 2; ++i) { int R, C; stage_rc(tid * 16 + i * 8192, R, C); const int Rb = Epi::PERM ? ((R & ~31) + perm32(R & 31)) : R;
        voffA[i] = (unsigned)(R * K + C) * 2u; voffB[i] = (unsigned)(Rb * K + C) * 2u; }
    const size_t kstep = (size_t)(BK * 2);
    const size_t hstep = (size_t)HALF * K * 2;
    const size_t tstep = 2 * hstep;
    const unsigned ldsw = (unsigned)wid * 1024u;
    const int aoff = lds_byte(wr * 64 + fr, fq * 8), boff = lds_byte(wc * 32 + fr, fq * 8);
#define PG8_SA(b, h) (((b) * 2 + (h)) * HTB)
#define PG8_SB(b, h) ((4 + (b) * 2 + (h)) * HTB)
#define PG8_STAGE(bufoff, gbase, voff) do { _Pragma("unroll") for (int _i = 0; _i < 2; ++_i) \
        __builtin_amdgcn_global_load_lds((const unsigned*)((const char*)(gbase) + (voff)[_i]), (PG8_LAS unsigned*)(lds + (bufoff) + ldsw + _i * 8192), 16, 0, 0); } while (0)
#define PG8_LDA(dst, b, h) do { _Pragma("unroll") for (int m = 0; m < 4; ++m) _Pragma("unroll") for (int k = 0; k < 2; ++k) dst[m][k] = *(const PG8_LAS bf16x8*)(lds + PG8_SA(b, h) + aoff + m * 2048 + k * 1024); } while (0)
#define PG8_LDB(dst, b, h) do { _Pragma("unroll") for (int n = 0; n < 2; ++n) _Pragma("unroll") for (int k = 0; k < 2; ++k) dst[n][k] = *(const PG8_LAS bf16x8*)(lds + PG8_SB(b, h) + boff + n * 2048 + k * 1024); } while (0)
#define PG8_MMA(ai, bj, At, Bt) do { __builtin_amdgcn_s_setprio(1); _Pragma("unroll") for (int m = 0; m < 4; ++m) _Pragma("unroll") for (int n = 0; n < 2; ++n) _Pragma("unroll") for (int k = 0; k < 2; ++k) \
        acc[ai][bj][m][n] = __builtin_amdgcn_mfma_f32_16x16x32_bf16(Bt[n][k], At[m][k], acc[ai][bj][m][n], 0, 0, 0); __builtin_amdgcn_s_setprio(0); } while (0)
#define PG8_WAIT_V(n) asm volatile("s_waitcnt vmcnt(" #n ")" ::: "memory")
#define PG8_WAIT_L(n) asm volatile("s_waitcnt lgkmcnt(" #n ")" ::: "memory")
#define PG8_BAR __builtin_amdgcn_s_barrier()
#define PG8_SCHED __builtin_amdgcn_sched_barrier(0)
    Unit cur, nxt; int ui = 0;
    if (!S.next(0, cur)) return;
    f32x4 acc[2][2][4][2];
#pragma unroll
    for (int a = 0; a < 2; ++a)
#pragma unroll
        for (int b = 0; b < 2; ++b)
#pragma unroll
            for (int m = 0; m < 4; ++m)
#pragma unroll
                for (int n = 0; n < 2; ++n) acc[a][b][m][n] = (f32x4){0.f, 0.f, 0.f, 0.f};
    bf16x8 At[4][2], B0[2][2], B1[2][2];
    const char* cA = (const char*)g.A + (size_t)cur.pm * tstep; const char* cB = (const char*)g.Bt + (size_t)cur.pn * tstep;
    S.a_ready(cur);
    if constexpr (SP2) {
        PG8_STAGE(PG8_SB(0, 0), cB, voffB); PG8_STAGE(PG8_SB(0, 1), cB + hstep, voffB); PG8_STAGE(PG8_SA(0, 0), cA, voffA); PG8_STAGE(PG8_SA(0, 1), cA + hstep, voffA);
        if (wr == 1) PG8_BAR;
        PG8_WAIT_V(2); PG8_BAR;
        PG8_STAGE(PG8_SB(1, 0), cB + kstep, voffB); PG8_STAGE(PG8_SA(1, 0), cA + kstep, voffA); PG8_STAGE(PG8_SB(1, 1), cB + hstep + kstep, voffB);
        PG8_WAIT_V(6); PG8_BAR;
    } else {
        PG8_STAGE(PG8_SB(0, 0), cB, voffB); PG8_STAGE(PG8_SA(0, 0), cA, voffA); PG8_STAGE(PG8_SB(0, 1), cB + hstep, voffB); PG8_STAGE(PG8_SA(0, 1), cA + hstep, voffA);
        if (wr == 1) PG8_BAR;
        PG8_WAIT_V(4); PG8_BAR;
        PG8_STAGE(PG8_SB(1, 0), cB + kstep, voffB); PG8_STAGE(PG8_SA(1, 0), cA + kstep, voffA); PG8_STAGE(PG8_SB(1, 1), cB + hstep + kstep, voffB);
        PG8_WAIT_V(6); PG8_BAR;
    }
    for (;;) {
        const bool has_next = S.next(ui + 1, nxt);
        const char* nA = has_next ? (const char*)g.A + (size_t)nxt.pm * tstep : cA; const char* nB = has_next ? (const char*)g.Bt + (size_t)nxt.pn * tstep : cB;
        for (int t = 0; t < nt; t += 2) {
            const bool last = (t == nt - 2);
            const char* a1 = cA + (size_t)(t + 1) * kstep;
            const char* a2 = last ? nA : cA + (size_t)(t + 2) * kstep; const char* b2 = last ? nB : cB + (size_t)(t + 2) * kstep;
            const char* a3 = a2 + kstep; const char* b3 = b2 + kstep;
            if (last && has_next) S.a_ready(nxt);
            if constexpr (SP2) {
            PG8_LDB(B0, 0, 0); PG8_LDB(B1, 0, 1); PG8_SCHED; PG8_LDA(At, 0, 0); PG8_STAGE(PG8_SA(1, 1), a1 + hstep, voffA);
            PG8_WAIT_V(8); PG8_WAIT_L(0); PG8_BAR; PG8_MMA(0, 0, At, B0); PG8_MMA(0, 1, At, B1); PG8_BAR; PG8_SCHED;
            PG8_LDA(At, 0, 1); PG8_STAGE(PG8_SB(0, 0), b2, voffB); PG8_STAGE(PG8_SB(0, 1), b2 + hstep, voffB); PG8_STAGE(PG8_SA(0, 0), a2, voffA);
            PG8_WAIT_V(8); PG8_WAIT_L(0); PG8_BAR; PG8_MMA(1, 0, At, B0); PG8_MMA(1, 1, At, B1); PG8_BAR; PG8_SCHED;
            PG8_LDB(B0, 1, 0); PG8_LDB(B1, 1, 1); PG8_SCHED; PG8_LDA(At, 1, 0); PG8_STAGE(PG8_SA(0, 1), a2 + hstep, voffA);
            PG8_WAIT_V(8); PG8_WAIT_L(0); PG8_BAR; PG8_MMA(0, 0, At, B0); PG8_MMA(0, 1, At, B1); PG8_BAR; PG8_SCHED;
            PG8_LDA(At, 1, 1); PG8_STAGE(PG8_SB(1, 0), b3, voffB); PG8_STAGE(PG8_SB(1, 1), b3 + hstep, voffB); PG8_STAGE(PG8_SA(1, 0), a3, voffA);
            PG8_WAIT_V(8); PG8_WAIT_L(0); PG8_BAR; PG8_MMA(1, 0, At, B0); PG8_MMA(1, 1, At, B1); PG8_BAR; PG8_SCHED;
            } else {
            PG8_LDB(B0, 0, 0); PG8_SCHED; PG8_LDA(At, 0, 0); PG8_STAGE(PG8_SA(1, 1), a1 + hstep, voffA);
            PG8_WAIT_L(8); PG8_BAR; PG8_WAIT_L(0); PG8_MMA(0, 0, At, B0); PG8_BAR; PG8_SCHED;
            PG8_LDB(B1, 0, 1); PG8_STAGE(PG8_SB(0, 0), b2, voffB);
            PG8_BAR; PG8_WAIT_L(0); PG8_MMA(0, 1, At, B1); PG8_BAR;
            PG8_LDA(At, 0, 1); PG8_STAGE(PG8_SA(0, 0), a2, voffA);
            PG8_BAR; PG8_WAIT_L(0); PG8_MMA(1, 0, At, B0); PG8_BAR; PG8_SCHED;
            PG8_STAGE(PG8_SB(0, 1), b2 + hstep, voffB);
            PG8_WAIT_V(6); PG8_BAR; PG8_MMA(1, 1, At, B1); PG8_BAR;
            PG8_LDB(B0, 1, 0); PG8_SCHED; PG8_LDA(At, 1, 0); PG8_STAGE(PG8_SA(0, 1), a2 + hstep, voffA);
            PG8_WAIT_L(8); PG8_BAR; PG8_WAIT_L(0); PG8_MMA(0, 0, At, B0); PG8_BAR; PG8_SCHED;
            PG8_LDB(B1, 1, 1); PG8_STAGE(PG8_SB(1, 0), b3, voffB);
            PG8_BAR; PG8_WAIT_L(0); PG8_MMA(0, 1, At, B1); PG8_BAR;
            PG8_LDA(At, 1, 1); PG8_STAGE(PG8_SA(1, 0), a3, voffA);
            PG8_BAR; PG8_WAIT_L(0); PG8_MMA(1, 0, At, B0); PG8_BAR; PG8_SCHED;
            PG8_STAGE(PG8_SB(1, 1), b3 + hstep, voffB);
            PG8_WAIT_V(6); PG8_BAR; PG8_MMA(1, 1, At, B1); PG8_BAR;
            }
        }
        if constexpr (ALIGN_EPI) { if (wr == 0) PG8_BAR; }
        if constexpr (!Epi::AFTER_DRAIN) { E(acc, cur, wr, wc, fr, fq); S.done(cur); }
        if (!has_next) break;
#pragma unroll
        for (int a = 0; a < 2; ++a)
#pragma unroll
            for (int b = 0; b < 2; ++b)
#pragma unroll
                for (int m = 0; m < 4; ++m)
#pragma unroll
                    for (int n = 0; n < 2; ++n) acc[a][b][m][n] = (f32x4){0.f, 0.f, 0.f, 0.f};
        cur = nxt; cA = nA; cB = nB; ++ui;
        if constexpr (ALIGN_EPI) { if (wr == 1) PG8_BAR; }
    }
    PG8_WAIT_V(0);
    if constexpr (!ALIGN_EPI) { if (wr == 0) PG8_BAR; }
    PG8_BAR;
    if constexpr (Epi::AFTER_DRAIN) { E.fused(acc, cur, wr, wc, fr, fq, lds, wid, lane); S.done(cur); }
#undef PG8_SA
#undef PG8_SB
#undef PG8_STAGE
#undef PG8_LDA
#undef PG8_LDB
#undef PG8_MMA
#undef PG8_WAIT_V
#undef PG8_WAIT_L
#undef PG8_BAR
#undef PG8_SCHED
}
}
constexpr int NWAVES = 8, NT = 512;
constexpr int BATCH = 2, SEQ = 8192, DM = 1024, DEPTH = 2, FF = 4096, INW = 3072, CW = 512, NH = 4, HD = 128, CK = 31;
constexpr int M = BATCH * SEQ;
constexpr int U_Q = 1024, U_K = 1536, U_V = 2048, U_G = 2560;
constexpr int NSUP = SEQ / 256;
constexpr size_t MiB = 1u << 20;
constexpr size_t WS_SSQ = 0;
constexpr size_t WS_BAR = 512 * 1024;
constexpr size_t WS_CS = 1 * MiB;
constexpr size_t WS_W = 6 * MiB;
constexpr size_t W_IN = 0, W_OUT = 6 * MiB, W_1 = 8 * MiB, W_2 = 16 * MiB, W_LAYER = 24 * MiB;
constexpr size_t WS_XB = 54 * MiB;
constexpr size_t WS_KV = 86 * MiB;
constexpr size_t WS_U = 102 * MiB;
constexpr size_t WS_MIX = 198 * MiB;
constexpr size_t WS_HFF = 102 * MiB;
constexpr size_t WS_END = 230 * MiB;
constexpr int LDS_BYTES = 147456;

#define LAS __attribute__((address_space(3)))
typedef unsigned short bf16;
typedef unsigned u32x4 __attribute__((ext_vector_type(4)));
typedef unsigned u32x2 __attribute__((ext_vector_type(2)));
typedef float f32x4 __attribute__((ext_vector_type(4)));
typedef float f32x2 __attribute__((ext_vector_type(2)));
typedef short bf16x8 __attribute__((ext_vector_type(8)));
#define LDS_WAIT() asm volatile("s_waitcnt lgkmcnt(0)" ::: "memory")
__device__ __forceinline__ unsigned f2bf(float f) { unsigned u = __builtin_bit_cast(unsigned, f); return (u + 0x7fffu + ((u >> 16) & 1u)) >> 16; }
__device__ __forceinline__ unsigned pk2(float lo, float hi) { return pg8::cvt_pk_bf16(lo, hi); }
__device__ __forceinline__ float bflo(unsigned w) { return __builtin_bit_cast(float, w << 16); }
__device__ __forceinline__ float bfhi(unsigned w) { return __builtin_bit_cast(float, w & 0xffff0000u); }
__device__ __forceinline__ float wave_sum(float v) {
#pragma unroll
    for (int o = 1; o < 64; o <<= 1) v += __shfl_xor(v, o);
    return v;
}
__device__ __forceinline__ float fast_sigmoid(float x) { return __builtin_amdgcn_rcpf(1.0f + __expf(-x)); }

struct Args {
    const float* x; const float* norm1_g; const float* w_in; const float* conv_w; const float* conv_b; const float* conv_ln_g; const float* conv_ln_b;
    const float* ret_norm_g; const float* w_out; const float* norm2_g; const float* w_ff1; const float* w_ff2; const float* final_g;
    float* out; unsigned char* ws; int ph_lo, ph_hi, coop, pad;
};

__device__ __forceinline__ void p0_transpose_item(const float* W, const float* gs, int K, int N, bf16* WT, LAS float* scr, int item, int lane) {
    const int nblk = N / 32, kb = item / nblk, nb = item % nblk, k0 = 64 * kb, n0 = 32 * nb;
#pragma unroll 8
    for (int i = 0; i < 32; ++i) { const int kk = 2 * i + (lane >> 5); const float g = gs ? gs[k0 + kk] : 1.0f; scr[kk * 33 + (lane & 31)] = W[(size_t)(k0 + kk) * N + n0 + (lane & 31)] * g; }
    LDS_WAIT(); asm volatile("" ::: "memory");
    const int c = lane & 7;
#pragma unroll
    for (int j = 0; j < 4; ++j) { const int n = (lane >> 3) + 8 * j; const LAS float* s = scr + (8 * c) * 33 + n;
        u32x4 o; o.x = pk2(s[0 * 33], s[1 * 33]); o.y = pk2(s[2 * 33], s[3 * 33]); o.z = pk2(s[4 * 33], s[5 * 33]); o.w = pk2(s[6 * 33], s[7 * 33]);
        *(u32x4*)(WT + (size_t)(n0 + n) * K + k0 + 8 * c) = o; }
    LDS_WAIT(); asm volatile("" ::: "memory");
}
__device__ __forceinline__ void p0_prologue(const Args& a, LAS unsigned char* lds, int tid, int lane, int wave) {
    LAS float* scr = (LAS float*)(lds + wave * 16384);
    const int gw = blockIdx.x * NWAVES + wave, NGW = gridDim.x * NWAVES;
    constexpr int I_IN = (DM / 64) * (INW / 32), I_O = (DM / 64) * (DM / 32), I_1 = (DM / 64) * (FF / 32), I_2 = (FF / 64) * (DM / 32), I_L = I_IN + I_O + I_1 + I_2;
    for (int it = gw; it < DEPTH * I_L; it += NGW) {
        const int l = it / I_L; int r = it % I_L; bf16* wl = (bf16*)(a.ws + WS_W + (size_t)l * W_LAYER);
        if (r < I_IN) { p0_transpose_item(a.w_in + (size_t)l * DM * INW, a.norm1_g + l * DM, DM, INW, (bf16*)((unsigned char*)wl + W_IN), scr, r, lane); continue; } r -= I_IN;
        if (r < I_O) { p0_transpose_item(a.w_out + (size_t)l * DM * DM, nullptr, DM, DM, (bf16*)((unsigned char*)wl + W_OUT), scr, r, lane); continue; } r -= I_O;
        if (r < I_1) { p0_transpose_item(a.w_ff1 + (size_t)l * DM * FF, a.norm2_g + l * DM, DM, FF, (bf16*)((unsigned char*)wl + W_1), scr, r, lane); continue; } r -= I_1;
        p0_transpose_item(a.w_ff2 + (size_t)l * FF * DM, nullptr, FF, DM, (bf16*)((unsigned char*)wl + W_2), scr, r, lane);
    }
    float* ssq = (float*)(a.ws + WS_SSQ); bf16* xb = (bf16*)(a.ws + WS_XB);
    for (int m = gw; m < M; m += NGW) {
        const f32x4* xr = (const f32x4*)(a.x + (size_t)m * DM) + lane; float s = 0.f; f32x4 v[4];
#pragma unroll
        for (int j = 0; j < 4; ++j) { v[j] = xr[64 * j]; s += (v[j].x * v[j].x + v[j].y * v[j].y) + (v[j].z * v[j].z + v[j].w * v[j].w); }
        s = wave_sum(s);
        u32x2* o8 = (u32x2*)(xb + (size_t)m * DM) + lane;
#pragma unroll
        for (int j = 0; j < 4; ++j) { u32x2 w; w.x = pk2(v[j].x, v[j].y); w.y = pk2(v[j].z, v[j].w); o8[64 * j] = w; }
        if (lane == 0) ssq[m] = s;
    }
    const int gt = blockIdx.x * NT + tid, NGT = gridDim.x * NT;
    for (int i = gt; i < 4 * M; i += NGT) ssq[M + i] = 0.f;
    f32x2* cs = (f32x2*)(a.ws + WS_CS);
    for (int i = gt; i < SEQ * 64; i += NGT) { const int pos = i >> 6, f = i & 63;
        const float invf = (float)exp2(-(double)f * (13.287712379549449 / 64.0));
        const float ang = (float)pos * invf;
        double rev = (double)ang * 0.15915494309189535; rev -= floor(rev);
        const float fr = (float)rev;
        cs[i] = (f32x2){__builtin_amdgcn_cosf(fr), __builtin_amdgcn_sinf(fr)}; }
}

__device__ __forceinline__ void conv_tile(const Args& a, int l, int tile, LAS unsigned char* lds, int tid, int lane, int wave) {
    LAS float* H = (LAS float*)lds;
    const bf16* u = (const bf16*)(a.ws + WS_U); bf16* mix = (bf16*)(a.ws + WS_MIX);
    const int b = tile >> 8, t0 = (tile & 255) * 32; const size_t rowbase = (size_t)b * SEQ;
#pragma unroll
    for (int hf = 0; hf < 2; ++hf) {
        u32x4 av[4], gv[4];
#pragma unroll
        for (int i4 = 0; i4 < 4; ++i4) { const int e = tid + NT * (4 * hf + i4), r = e >> 6, ch = (e & 63) * 8, t = t0 - 30 + r;
            av[i4] = (u32x4){0u, 0u, 0u, 0u}; gv[i4] = (u32x4){0u, 0u, 0u, 0u};
            if (e < 62 * 64 && t >= 0) { const bf16* p = u + (rowbase + t) * INW + ch; av[i4] = *(const u32x4*)p; gv[i4] = *(const u32x4*)(p + CW); } }
#pragma unroll
        for (int i4 = 0; i4 < 4; ++i4) { const int e = tid + NT * (4 * hf + i4), r = e >> 6, ch = (e & 63) * 8;
            if (e < 62 * 64) { f32x4 h0, h1;
                h0[0] = bflo(av[i4].x) * fast_sigmoid(bflo(gv[i4].x)); h0[1] = bfhi(av[i4].x) * fast_sigmoid(bfhi(gv[i4].x)); h0[2] = bflo(av[i4].y) * fast_sigmoid(bflo(gv[i4].y)); h0[3] = bfhi(av[i4].y) * fast_sigmoid(bfhi(gv[i4].y));
                h1[0] = bflo(av[i4].z) * fast_sigmoid(bflo(gv[i4].z)); h1[1] = bfhi(av[i4].z) * fast_sigmoid(bfhi(gv[i4].z)); h1[2] = bflo(av[i4].w) * fast_sigmoid(bflo(gv[i4].w)); h1[3] = bfhi(av[i4].w) * fast_sigmoid(bfhi(gv[i4].w));
                *(LAS f32x4*)(H + r * 512 + ch) = h0; *(LAS f32x4*)(H + r * 512 + ch + 4) = h1; } }
        asm volatile("" ::: "memory");
    }
    __syncthreads();
    asm volatile("" ::: "memory");
    const int cp = tid & 255, rg = tid >> 8;
    const float* cw = a.conv_w + (size_t)l * CK * CW + 2 * cp;
    const f32x2 bias = *(const f32x2*)(a.conv_b + l * CW + 2 * cp);
    f32x2 acc[16];
#pragma unroll
    for (int r = 0; r < 16; ++r) acc[r] = bias;
    {
        const LAS float* hp = H + (rg * 16) * 512 + 2 * cp;
        f32x2 win[16];
#pragma unroll
        for (int r = 0; r < 16; ++r) win[r] = *(const LAS f32x2*)(hp + r * 512);
#pragma unroll 4
        for (int j = 0; j < CK; ++j) {
            const f32x2 w = *(const f32x2*)(cw + j * CW);
            const int nr = (16 + j < 46) ? 16 + j : 45;
            const f32x2 hn = *(const LAS f32x2*)(hp + nr * 512);
#pragma unroll
            for (int r = 0; r < 16; ++r) acc[r] += w * win[r];
#pragma unroll
            for (int r = 0; r < 15; ++r) win[r] = win[r + 1];
            win[15] = hn;
        }
    }
    __syncthreads();
#pragma unroll
    for (int r = 0; r < 16; ++r) *(LAS f32x2*)(H + (rg * 16 + r) * 512 + 2 * cp) = acc[r];
    __syncthreads();
    const f32x4 g0 = *(const f32x4*)(a.conv_ln_g + l * CW + 8 * lane), g1 = *(const f32x4*)(a.conv_ln_g + l * CW + 8 * lane + 4);
    const f32x4 b0 = *(const f32x4*)(a.conv_ln_b + l * CW + 8 * lane), b1 = *(const f32x4*)(a.conv_ln_b + l * CW + 8 * lane + 4);
#pragma unroll
    for (int rr = 0; rr < 4; ++rr) { const int r = wave * 4 + rr;
        f32x4 v0 = *(const LAS f32x4*)(H + r * 512 + 8 * lane), v1 = *(const LAS f32x4*)(H + r * 512 + 8 * lane + 4);
        const float mu = wave_sum((v0[0] + v0[1]) + (v0[2] + v0[3]) + (v1[0] + v1[1]) + (v1[2] + v1[3])) * (1.0f / 512.0f);
        v0 = v0 - mu; v1 = v1 - mu;
        const float var = wave_sum((v0[0] * v0[0] + v0[1] * v0[1]) + (v0[2] * v0[2] + v0[3] * v0[3]) + (v1[0] * v1[0] + v1[1] * v1[1]) + (v1[2] * v1[2] + v1[3] * v1[3])) * (1.0f / 512.0f);
        const float rs = __builtin_amdgcn_rsqf(var + 1e-6f);
        v0 = v0 * rs * g0 + b0; v1 = v1 * rs * g1 + b1;
#pragma unroll
        for (int t = 0; t < 4; ++t) { v0[t] = v0[t] * fast_sigmoid(v0[t]); v1[t] = v1[t] * fast_sigmoid(v1[t]); }
        u32x4 o; o.x = pk2(v0[0], v0[1]); o.y = pk2(v0[2], v0[3]); o.z = pk2(v1[0], v1[1]); o.w = pk2(v1[2], v1[3]);
        *(u32x4*)(mix + (rowbase + t0 + r) * DM + 8 * lane) = o; }
    __syncthreads();
}

constexpr int R_QS = 0, R_KS = 17408, R_KT = 34816, R_VT = 53248, R_PS = 71680, R_ST = 80896, R_GP = 115712, R_RED = 116224;
constexpr int QS_LD = 136, KT_LD = 72, PS_LD = 72, ST_LD = 136;
typedef short s16x4 __attribute__((ext_vector_type(4)));

__device__ __forceinline__ void ret_setup_gp(LAS unsigned char* lds, int h, int tid) {
    LAS float* gp = (LAS float*)(lds + R_GP);
    if (tid <= 64) { const float gamma = 1.0f - exp2f(-5.0f - (float)h); gp[tid] = exp2f((float)tid * log2f(gamma)); }
}
#define FRAG(base, ld, r, k) (*(const LAS bf16x8*)((base) + (r) * (ld) + (k)))
__device__ __forceinline__ bf16x8 frag_tr(const LAS bf16* base, int ld, int k0, int c0, int lane) {
#ifdef TR_MANUAL
    { const int fq_ = lane >> 4, fr_ = lane & 15; bf16x8 r;
#pragma unroll
      for (int t = 0; t < 8; ++t) r[t] = (short)base[(k0 + 8 * fq_ + t) * ld + c0 + fr_];
      return r; }
#endif
    const int g = lane >> 4, q = (lane & 15) >> 2, p = lane & 3;
    const LAS bf16* a = base + (k0 + 8 * g + q) * ld + c0 + 4 * p;
    const s16x4 lo = __builtin_amdgcn_ds_read_tr16_b64_v4i16((LAS s16x4*)a), hi = __builtin_amdgcn_ds_read_tr16_b64_v4i16((LAS s16x4*)(a + 4 * ld));
    return __builtin_shufflevector(lo, hi, 0, 1, 2, 3, 4, 5, 6, 7);
}
struct ChunkRegs { u32x4 k1, k2, q1, q2, v0, v1; f32x4 c0, c1, c2, c3; };
template <bool NEED_Q>
__device__ __forceinline__ void ret_issue_loads(ChunkRegs& R, const Args& a, size_t row0, int pos0, int h, int tid) {
    const bf16* u = (const bf16*)(a.ws + WS_U); const f32x4* cs = (const f32x4*)(a.ws + WS_CS);
    const int j = tid >> 3, c = tid & 7;
    const bf16* rowp = u + (row0 + j) * INW + h * HD;
    const f32x4* csp = cs + ((size_t)(pos0 + j) * 64 + 8 * c) / 2;
    R.k1 = *(const u32x4*)(rowp + U_K + 8 * c); R.k2 = *(const u32x4*)(rowp + U_K + 64 + 8 * c);
    if (NEED_Q) { R.q1 = *(const u32x4*)(rowp + U_Q + 8 * c); R.q2 = *(const u32x4*)(rowp + U_Q + 64 + 8 * c); }
    R.c0 = csp[0]; R.c1 = csp[1]; R.c2 = csp[2]; R.c3 = csp[3];
    R.v0 = *(const u32x4*)(u + (row0 + (tid >> 4)) * INW + U_V + h * HD + 8 * (tid & 15));
    R.v1 = *(const u32x4*)(u + (row0 + 32 + (tid >> 4)) * INW + U_V + h * HD + 8 * (tid & 15));
}
template <bool ROWS, bool TRANS>
__device__ __forceinline__ void rot_store(LAS bf16* dst, LAS bf16* dstT, int j, int c, float wk, const u32x4 a1, const u32x4 a2, const ChunkRegs& R, float sc) {
    const float co[8] = {R.c0[0], R.c0[2], R.c1[0], R.c1[2], R.c2[0], R.c2[2], R.c3[0], R.c3[2]};
    const float si[8] = {R.c0[1], R.c0[3], R.c1[1], R.c1[3], R.c2[1], R.c2[3], R.c3[1], R.c3[3]};
    const float x1[8] = {bflo(a1.x), bfhi(a1.x), bflo(a1.y), bfhi(a1.y), bflo(a1.z), bfhi(a1.z), bflo(a1.w), bfhi(a1.w)};
    const float x2[8] = {bflo(a2.x), bfhi(a2.x), bflo(a2.y), bfhi(a2.y), bflo(a2.z), bfhi(a2.z), bflo(a2.w), bfhi(a2.w)};
    float y1[8], y2[8];
#pragma unroll
    for (int t = 0; t < 8; ++t) { y1[t] = (x1[t] * co[t] - x2[t] * si[t]) * sc; y2[t] = (x1[t] * si[t] + x2[t] * co[t]) * sc; }
    if (ROWS) {
        u32x4 o1, o2; o1.x = pk2(y1[0], y1[1]); o1.y = pk2(y1[2], y1[3]); o1.z = pk2(y1[4], y1[5]); o1.w = pk2(y1[6], y1[7]);
        o2.x = pk2(y2[0], y2[1]); o2.y = pk2(y2[2], y2[3]); o2.z = pk2(y2[4], y2[5]); o2.w = pk2(y2[6], y2[7]);
        *(LAS u32x4*)(dst + j * QS_LD + 8 * c) = o1; *(LAS u32x4*)(dst + j * QS_LD + 64 + 8 * c) = o2; }
    if (TRANS) {
#pragma unroll
        for (int t = 0; t < 8; ++t) { dstT[(8 * c + t) * KT_LD + j] = (bf16)f2bf(y1[t] * wk); dstT[(64 + 8 * c + t) * KT_LD + j] = (bf16)f2bf(y2[t] * wk); } }
}
template <bool NEED_Q>
__device__ __forceinline__ void ret_store_chunk(const ChunkRegs& R, LAS unsigned char* lds, int tid) {
    LAS bf16* Qs = (LAS bf16*)(lds + R_QS); LAS bf16* Ks = (LAS bf16*)(lds + R_KS); LAS bf16* KT = (LAS bf16*)(lds + R_KT); LAS bf16* VT = (LAS bf16*)(lds + R_VT);
    const LAS float* gp = (const LAS float*)(lds + R_GP);
    const int j = tid >> 3, c = tid & 7;
    rot_store<NEED_Q, true>(Ks, KT, j, c, gp[63 - j], R.k1, R.k2, R, 0.08838834764831845f);
    if (NEED_Q) rot_store<true, false>(Qs, nullptr, j, c, 1.0f, R.q1, R.q2, R, 1.0f);
    { const int j2 = tid >> 4, c2 = tid & 15; LAS bf16* vt = VT + (8 * c2) * KT_LD + j2;
      vt[0 * KT_LD] = (bf16)(R.v0.x & 0xffffu); vt[1 * KT_LD] = (bf16)(R.v0.x >> 16); vt[2 * KT_LD] = (bf16)(R.v0.y & 0xffffu); vt[3 * KT_LD] = (bf16)(R.v0.y >> 16);
      vt[4 * KT_LD] = (bf16)(R.v0.z & 0xffffu); vt[5 * KT_LD] = (bf16)(R.v0.z >> 16); vt[6 * KT_LD] = (bf16)(R.v0.w & 0xffffu); vt[7 * KT_LD] = (bf16)(R.v0.w >> 16);
      vt += 32;
      vt[0 * KT_LD] = (bf16)(R.v1.x & 0xffffu); vt[1 * KT_LD] = (bf16)(R.v1.x >> 16); vt[2 * KT_LD] = (bf16)(R.v1.y & 0xffffu); vt[3 * KT_LD] = (bf16)(R.v1.y >> 16);
      vt[4 * KT_LD] = (bf16)(R.v1.z & 0xffffu); vt[5 * KT_LD] = (bf16)(R.v1.z >> 16); vt[6 * KT_LD] = (bf16)(R.v1.w & 0xffffu); vt[7 * KT_LD] = (bf16)(R.v1.w >> 16); }
}
__device__ __forceinline__ void ret_kv_update(f32x4 (&S)[8], LAS unsigned char* lds, int wave, int lane) {
    const LAS bf16* KT = (const LAS bf16*)(lds + R_KT); const LAS bf16* VT = (const LAS bf16*)(lds + R_VT); const float g64 = ((const LAS float*)(lds + R_GP))[64];
    const int fr = lane & 15, fq = lane >> 4;
    const bf16x8 a0 = FRAG(KT, KT_LD, 16 * wave + fr, 8 * fq), a1 = FRAG(KT, KT_LD, 16 * wave + fr, 32 + 8 * fq);
#pragma unroll
    for (int et = 0; et < 8; ++et) { S[et] = S[et] * g64;
        S[et] = __builtin_amdgcn_mfma_f32_16x16x32_bf16(a0, FRAG(VT, KT_LD, 16 * et + fr, 8 * fq), S[et], 0, 0, 0);
        S[et] = __builtin_amdgcn_mfma_f32_16x16x32_bf16(a1, FRAG(VT, KT_LD, 16 * et + fr, 32 + 8 * fq), S[et], 0, 0, 0); }
}
__device__ __forceinline__ void ret_kv_unit(const Args& a, int unit, LAS unsigned char* lds, int tid, int lane, int wave) {
    const int N = unit & 31, bh = unit >> 5, h = bh & 3, b = bh >> 2;
    if (N == NSUP - 1) return;
    ret_setup_gp(lds, h, tid);
    f32x4 S[8];
#pragma unroll
    for (int et = 0; et < 8; ++et) S[et] = (f32x4){0.f, 0.f, 0.f, 0.f};
    const size_t row0 = (size_t)b * SEQ + (size_t)N * 256;
    ChunkRegs R; ret_issue_loads<false>(R, a, row0, N * 256, h, tid);
    for (int c = 0; c < 4; ++c) {
        __syncthreads();
        ret_store_chunk<false>(R, lds, tid);
        if (c < 3) ret_issue_loads<false>(R, a, row0 + (c + 1) * 64, N * 256 + (c + 1) * 64, h, tid);
        __syncthreads();
        ret_kv_update(S, lds, wave, lane);
    }
    f32x4* kv = (f32x4*)(a.ws + WS_KV) + ((size_t)(unit * 8 + wave) * 8) * 64 + lane;
#pragma unroll
    for (int et = 0; et < 8; ++et) kv[et * 64] = S[et];
    __syncthreads();
}
__device__ __forceinline__ void ret_scan(const Args& a, int tid) {
    for (int gt = blockIdx.x * NT + tid; gt < 8 * 16384; gt += gridDim.x * NT) {
    const int bh = gt >> 14, e = gt & 16383, h = bh & 3;
    float* p = (float*)(a.ws + WS_KV) + (size_t)bh * 32 * 16384 + e;
    const float gamma = 1.0f - exp2f(-5.0f - (float)h); const float G = exp2f(256.0f * log2f(gamma));
    float v[31];
#pragma unroll
    for (int n = 0; n < 31; ++n) v[n] = p[(size_t)n * 16384];
    float s = 0.f;
#pragma unroll
    for (int n = 0; n < 31; ++n) { s = s * G + v[n]; p[(size_t)n * 16384] = s; }
    }
}
__device__ __forceinline__ void ret_out_unit(const Args& a, int l, int unit, LAS unsigned char* lds, int tid, int lane, int wave) {
    const int N = unit & 31, bh = unit >> 5, h = bh & 3, b = bh >> 2, fr = lane & 15, fq = lane >> 4;
    const bf16* u = (const bf16*)(a.ws + WS_U); bf16* mix = (bf16*)(a.ws + WS_MIX);
    LAS bf16* Qs = (LAS bf16*)(lds + R_QS); LAS bf16* Ks = (LAS bf16*)(lds + R_KS); LAS bf16* VT = (LAS bf16*)(lds + R_VT);
    LAS bf16* Ps = (LAS bf16*)(lds + R_PS); LAS bf16* ST = (LAS bf16*)(lds + R_ST);
    LAS float* gp = (LAS float*)(lds + R_GP); LAS float* red = (LAS float*)(lds + R_RED);
    const size_t row0 = (size_t)b * SEQ + (size_t)N * 256;
    ChunkRegs R; ret_issue_loads<true>(R, a, row0, N * 256, h, tid);
    __syncthreads();
    ret_setup_gp(lds, h, tid);
    f32x4 S[8];
#pragma unroll
    for (int et = 0; et < 8; ++et) S[et] = (f32x4){0.f, 0.f, 0.f, 0.f};
    if (N > 0) { const f32x4* kv = (const f32x4*)(a.ws + WS_KV) + ((size_t)((unit - 1) * 8 + wave) * 8) * 64 + lane;
#pragma unroll
        for (int et = 0; et < 8; ++et) S[et] = kv[et * 64]; }
    const int it = wave & 3, wh = wave >> 2, il = it * 16 + fr;
    const f32x4 ng[4] = { *(const f32x4*)(a.ret_norm_g + l * CW + h * HD + (4 * wh + 0) * 16 + 4 * fq), *(const f32x4*)(a.ret_norm_g + l * CW + h * HD + (4 * wh + 1) * 16 + 4 * fq),
                          *(const f32x4*)(a.ret_norm_g + l * CW + h * HD + (4 * wh + 2) * 16 + 4 * fq), *(const f32x4*)(a.ret_norm_g + l * CW + h * HD + (4 * wh + 3) * 16 + 4 * fq) };
    for (int c = 0; c < 4; ++c) {
        __syncthreads();
#pragma unroll
        for (int et = 0; et < 8; ++et) { u32x2 w; w.x = pk2(S[et][0], S[et][1]); w.y = pk2(S[et][2], S[et][3]); *(LAS u32x2*)(ST + (16 * et + fr) * ST_LD + 16 * wave + 4 * fq) = w; }
        ret_store_chunk<true>(R, lds, tid);
        const size_t row = row0 + c * 64 + il;
        u32x2 gv[4];
#pragma unroll
        for (int t = 0; t < 4; ++t) gv[t] = *(const u32x2*)(u + row * INW + U_G + h * HD + (4 * wh + t) * 16 + 4 * fq);
        if (c < 3) ret_issue_loads<true>(R, a, row0 + (c + 1) * 64, N * 256 + (c + 1) * 64, h, tid);
        __syncthreads();
#pragma unroll
        for (int jj2 = 0; jj2 < 2; ++jj2) { const int jt = 2 * wh + jj2; f32x4 sc = {0.f, 0.f, 0.f, 0.f};
#pragma unroll
            for (int ks = 0; ks < 4; ++ks) sc = __builtin_amdgcn_mfma_f32_16x16x32_bf16(FRAG(Ks, QS_LD, jt * 16 + fr, ks * 32 + 8 * fq), FRAG(Qs, QS_LD, it * 16 + fr, ks * 32 + 8 * fq), sc, 0, 0, 0);
            float p[4];
#pragma unroll
            for (int r = 0; r < 4; ++r) { const int jl = jt * 16 + 4 * fq + r; const int dd = il > jl ? il - jl : jl - il; p[r] = sc[r] * gp[dd]; }
            u32x2 w; w.x = pk2(p[0], p[1]); w.y = pk2(p[2], p[3]); *(LAS u32x2*)(Ps + il * PS_LD + jt * 16 + 4 * fq) = w; }
        __syncthreads();
        f32x4 o[4]; const float wq = gp[il + 1]; float qs = 0.f;
#pragma unroll
        for (int t = 0; t < 4; ++t) { const int et = 4 * wh + t; f32x4 acc = {0.f, 0.f, 0.f, 0.f};
#pragma unroll
            for (int ks = 0; ks < 4; ++ks) acc = __builtin_amdgcn_mfma_f32_16x16x32_bf16(FRAG(ST, ST_LD, et * 16 + fr, ks * 32 + 8 * fq), FRAG(Qs, QS_LD, it * 16 + fr, ks * 32 + 8 * fq), acc, 0, 0, 0);
            acc = acc * wq;
#pragma unroll
            for (int ks = 0; ks < 2; ++ks) acc = __builtin_amdgcn_mfma_f32_16x16x32_bf16(FRAG(VT, KT_LD, et * 16 + fr, ks * 32 + 8 * fq), FRAG(Ps, PS_LD, it * 16 + fr, ks * 32 + 8 * fq), acc, 0, 0, 0);
            o[t] = acc; qs += (acc[0] * acc[0] + acc[1] * acc[1]) + (acc[2] * acc[2] + acc[3] * acc[3]); }
        qs += __shfl_xor(qs, 16); qs += __shfl_xor(qs, 32);
        if (fq == 0) red[wh * 64 + il] = qs;
        if (c < 3) ret_kv_update(S, lds, wave, lane);
        __syncthreads();
        const float rs = __builtin_amdgcn_rsqf((red[il] + red[64 + il]) * (1.0f / 128.0f) + 1e-6f);
#pragma unroll
        for (int t = 0; t < 4; ++t) { const int e0 = (4 * wh + t) * 16 + 4 * fq;
            const float g0 = bflo(gv[t].x), g1 = bfhi(gv[t].x), g2 = bflo(gv[t].y), g3 = bfhi(gv[t].y);
            const float y0 = o[t][0] * rs * ng[t][0] * (g0 * fast_sigmoid(g0)), y1 = o[t][1] * rs * ng[t][1] * (g1 * fast_sigmoid(g1));
            const float y2 = o[t][2] * rs * ng[t][2] * (g2 * fast_sigmoid(g2)), y3 = o[t][3] * rs * ng[t][3] * (g3 * fast_sigmoid(g3));
            u32x2 w; w.x = pk2(y0, y1); w.y = pk2(y2, y3); *(u32x2*)(mix + row * DM + CW + h * HD + e0) = w; }
    }
    __syncthreads();
}

__device__ __forceinline__ void final_norm(const Args& a, int lane, int wave) {
    const float* ssq = (const float*)(a.ws + WS_SSQ) + 4 * M;
    const int gw = blockIdx.x * NWAVES + wave, NGW = gridDim.x * NWAVES;
    f32x4 g[4];
#pragma unroll
    for (int j = 0; j < 4; ++j) g[j] = ((const f32x4*)a.final_g)[lane + 64 * j];
    for (int m = gw; m < M; m += NGW) { f32x4* xr = (f32x4*)(a.out + (size_t)m * DM) + lane; const float rs = __builtin_amdgcn_rsqf(ssq[m] * (1.0f / 1024.0f) + 1e-6f);
#pragma unroll
        for (int j = 0; j < 4; ++j) { const f32x4 v = xr[64 * j]; xr[64 * j] = v * rs * g[j]; } }
}

#define RLX_AGENT __ATOMIC_RELAXED, __HIP_MEMORY_SCOPE_AGENT
#define XB_TMO      128
#define XB_XCNT(j)  (256  + 64 * (j))
#define XB_XSUB(j)  (1280 + 64 * (j))
#define XB_XGEN(j)  (2304 + 64 * (j))
#define XB_TOP      3328
#define XB_TOPGEN   3392
#define XCD_BAR_WORDS 3456
#define XB_SPIN_CAP (1u << 18)

__device__ __forceinline__ unsigned xb_ld(unsigned* p)              { return __hip_atomic_load(p, __ATOMIC_RELAXED, __HIP_MEMORY_SCOPE_AGENT); }
__device__ __forceinline__ unsigned xb_add(unsigned* p, unsigned v) { return __hip_atomic_fetch_add(p, v, __ATOMIC_RELAXED, __HIP_MEMORY_SCOPE_AGENT); }
__device__ __forceinline__ unsigned xb_xcc_id() { return (unsigned)__builtin_amdgcn_s_getreg((3 << 11) | 20) & 0xFu; }
#define XB_SPIN(cond, bar) do { unsigned _sp = 0; while (cond) { __builtin_amdgcn_s_sleep(1); \
    if ((++_sp & 255u) == 0u) { if (xb_ld(&(bar)[XB_TMO])) break; if (_sp > XB_SPIN_CAP) { atomicAdd(&(bar)[XB_TMO], 1u); break; } } } } while (0)

struct XcdBarrier {
    unsigned* bar; unsigned x;
    volatile LAS unsigned* st;
};

__device__ __forceinline__ XcdBarrier xcd_barrier_post(unsigned* bar, volatile LAS unsigned* st) {
    XcdBarrier b; b.bar = bar; b.x = xb_xcc_id(); b.st = st;
    if (threadIdx.x == 0) (void)xb_add(&bar[XB_XCNT(b.x)], 1u);
    return b;
}
__device__ __forceinline__ void xcd_barrier_complete(unsigned* bar, unsigned x, unsigned& nloc, unsigned& nx) {
    const unsigned G = gridDim.x * gridDim.y * gridDim.z;
    unsigned sum, cnt, mine, sp = 0u;
    for (;;) {
        sum = 0u; cnt = 0u; mine = 0u;
#pragma unroll
        for (unsigned j = 0; j < 16; ++j) { const unsigned c = xb_ld(&bar[XB_XCNT(j)]); sum += c; cnt += (c > 0u) ? 1u : 0u; mine = (j == x) ? c : mine; }
        if (sum == G) break;
        __builtin_amdgcn_s_sleep(1);
        if ((++sp & 255u) == 0u) { if (xb_ld(&bar[XB_TMO])) break; if (sp > XB_SPIN_CAP) { atomicAdd(&bar[XB_TMO], 1u); break; } }
    }
    nloc = mine > 0u ? mine : 1u; nx = cnt > 0u ? cnt : 1u;
}

__device__ __forceinline__ void xcd_barrier(const XcdBarrier& b) {
    asm volatile("s_waitcnt vmcnt(0)" ::: "memory");
    __syncthreads();
    if (threadIdx.x == 0) {
        unsigned* bar = b.bar;
        __builtin_amdgcn_s_waitcnt(0);
        unsigned nloc = b.st[0], nx = b.st[1];
        if (nloc == 0u) { xcd_barrier_complete(bar, b.x, nloc, nx); b.st[0] = nloc; b.st[1] = nx; }
        const unsigned old = xb_add(&bar[XB_XSUB(b.x)], 1u);
        const unsigned gen = old / nloc;
        if (old + 1u == (gen + 1u) * nloc) {
            __builtin_amdgcn_fence(__ATOMIC_RELEASE, "agent");
            asm volatile("s_waitcnt vmcnt(0)" ::: "memory");
            const unsigned og = xb_add(&bar[XB_TOP], 1u);
            const unsigned tg = og / nx;
            if (og + 1u == (tg + 1u) * nx) xb_add(&bar[XB_TOPGEN], 1u);
            else XB_SPIN(xb_ld(&bar[XB_TOPGEN]) == tg, bar);
            __builtin_amdgcn_fence(__ATOMIC_ACQUIRE, "agent");
            xb_add(&bar[XB_XGEN(b.x)], 1u);
            asm volatile("s_waitcnt vmcnt(0)" ::: "memory");
        } else {
            XB_SPIN(xb_ld(&bar[XB_XGEN(b.x)]) == gen, bar);
            __builtin_amdgcn_fence(__ATOMIC_ACQUIRE, "agent");
            asm volatile("s_waitcnt vmcnt(0)" ::: "memory");
        }
    }
    __syncthreads();
}

constexpr int N_PHASES = 2 + 7 * DEPTH;
#ifndef DUP_MASK
#define DUP_MASK 0
#endif
#ifndef PH_MASK
#define PH_MASK 255
#endif
__global__ void __launch_bounds__(NT, 2) fwd_megakernel(Args a) {
    extern __shared__ __attribute__((aligned(16))) unsigned char lds_raw[];
    LAS unsigned char* lds = (LAS unsigned char*)lds_raw;
#define PHASE_TID() int tid = threadIdx.x; asm volatile("" : "+v"(tid)); const int lane = tid & 63, wave = __builtin_amdgcn_readfirstlane(tid >> 6); (void)lane; (void)wave
    const int lo = a.ph_lo, hi = a.ph_hi;
    volatile LAS unsigned* bst = (volatile LAS unsigned*)(lds + LDS_BYTES - 256);
    if (threadIdx.x < 2) bst[threadIdx.x] = 0u;
    __syncthreads();
    XcdBarrier bar; bar.bar = (unsigned*)(a.ws + WS_BAR); bar.x = 0; bar.st = bst;
    if (a.coop) bar = xcd_barrier_post((unsigned*)(a.ws + WS_BAR), bst);
#define IN(k) (lo <= (k) && (k) < hi)
#define SEAM(k) do { if (IN(k) && IN((k) + 1)) { if (a.coop == 2) cg::this_grid().sync(); else xcd_barrier(bar); } } while (0)
    float* ssq = (float*)(a.ws + WS_SSQ);
    bf16* xb = (bf16*)(a.ws + WS_XB); bf16* U = (bf16*)(a.ws + WS_U); bf16* MIX = (bf16*)(a.ws + WS_MIX); bf16* HFF = (bf16*)(a.ws + WS_HFF);
    if (IN(0) && (PH_MASK & 1)) for (int rep = 0; rep < ((DUP_MASK & 1) ? 2 : 1); ++rep) { PHASE_TID(); p0_prologue(a, lds, tid, lane, wave); }
    SEAM(0);
    for (int l = 0; l < DEPTH; ++l) {
        const int pb = 1 + 7 * l;
        const unsigned char* wl = a.ws + WS_W + (size_t)l * W_LAYER;
        if (IN(pb + 0) && (PH_MASK & 2)) for (int rep = 0; rep < ((DUP_MASK & 2) ? 2 : 1); ++rep) {
            PHASE_TID(); pg8::Gemm g{xb, (const bf16*)(wl + W_IN), M, INW, DM}; pg8::StaticOrder S; S.init(M, INW, gridDim.x, blockIdx.x);
            pg8::EpiScale<0> E{U, INW, ssq + (2 * l) * M};
            pg8::gemm_phase<pg8::EpiScale<0>, pg8::StaticOrder, true, true>(lds, g, S, E, tid);
        }
        SEAM(pb + 0);
        if (IN(pb + 1) && (PH_MASK & 4)) for (int rep = 0; rep < ((DUP_MASK & 4) ? 2 : 1); ++rep) {
            PHASE_TID();
            for (int it = blockIdx.x; it < 256; it += gridDim.x) ret_kv_unit(a, it, lds, tid, lane, wave);
            asm volatile("" ::: "memory");
            for (int it = blockIdx.x; it < 512; it += gridDim.x) conv_tile(a, l, it, lds, tid, lane, wave);
        }
        SEAM(pb + 1);
        if (IN(pb + 2)) { PHASE_TID(); ret_scan(a, tid); }
        SEAM(pb + 2);
        if (IN(pb + 3) && (PH_MASK & 8)) for (int rep = 0; rep < ((DUP_MASK & 8) ? 2 : 1); ++rep) {
            PHASE_TID();
            for (int it = blockIdx.x; it < 256; it += gridDim.x) ret_out_unit(a, l, it, lds, tid, lane, wave);
        }
        SEAM(pb + 3);
        if (IN(pb + 4) && (PH_MASK & 16)) for (int rep = ((DUP_MASK & 16) ? 0 : 1); rep < 2; ++rep) {
            PHASE_TID(); pg8::Gemm g{MIX, (const bf16*)(wl + W_OUT), M, DM, DM}; pg8::StaticOrder S; S.init(M, DM, gridDim.x, blockIdx.x);
            pg8::EpiResid E{(l == 0 && rep == 1) ? a.x : a.out, a.out, xb, rep ? ssq + (2 * l + 1) * M : ssq, rep ? 1.0f : 0.0f};
            pg8::gemm_phase<pg8::EpiResid, pg8::StaticOrder, true, true>(lds, g, S, E, tid);
        }
        SEAM(pb + 4);
        if (IN(pb + 5) && (PH_MASK & 32)) for (int rep = 0; rep < ((DUP_MASK & 32) ? 2 : 1); ++rep) {
            PHASE_TID(); pg8::Gemm g{xb, (const bf16*)(wl + W_1), M, FF, DM}; pg8::StaticOrder S; S.init(M, FF, gridDim.x, blockIdx.x);
            pg8::EpiScale<1> E{HFF, FF, ssq + (2 * l + 1) * M};
            pg8::gemm_phase<pg8::EpiScale<1>, pg8::StaticOrder, true, true>(lds, g, S, E, tid);
        }
        SEAM(pb + 5);
        if (IN(pb + 6) && (PH_MASK & 64)) for (int rep = ((DUP_MASK & 64) ? 0 : 1); rep < 2; ++rep) {
            PHASE_TID(); pg8::Gemm g{HFF, (const bf16*)(wl + W_2), M, DM, FF}; pg8::StaticOrder S; S.init(M, DM, gridDim.x, blockIdx.x);
            pg8::EpiResid E{a.out, a.out, xb, rep ? ssq + (2 * l + 2) * M : ssq, rep ? 1.0f : 0.0f};
            pg8::gemm_phase<pg8::EpiResid, pg8::StaticOrder, true, true>(lds, g, S, E, tid);
        }
        SEAM(pb + 6);
    }
    if (IN(N_PHASES - 1) && (PH_MASK & 128)) { PHASE_TID(); final_norm(a, lane, wave); }
#undef IN
#undef SEAM
}

#ifndef MK_ONE_LAUNCH
#define MK_ONE_LAUNCH 1
#endif
extern "C" void kernel_launch(void* const* d_in, const int* in_sizes, int n_in, void* d_out, int out_size, void* d_ws, size_t ws_size, hipStream_t stream) {
    static int grid = 0;
    if (grid == 0) {
        if (n_in != 13 || in_sizes[0] != M * DM || out_size != M * DM || ws_size < WS_END) { fprintf(stderr, "kernel_launch: unexpected shapes (n_in %d in0 %d out %d ws %zu); nothing launched\n", n_in, n_in > 0 ? in_sizes[0] : -1, out_size, ws_size); grid = -1; return; }
        int dev = 0, cus = 0, per_cu = 0;
        if (hipGetDevice(&dev) != hipSuccess || hipDeviceGetAttribute(&cus, hipDeviceAttributeMultiprocessorCount, dev) != hipSuccess) { grid = -1; return; }
        if (hipFuncSetAttribute((const void*)fwd_megakernel, hipFuncAttributeMaxDynamicSharedMemorySize, LDS_BYTES) != hipSuccess) { fprintf(stderr, "kernel_launch: hipFuncSetAttribute failed\n"); grid = -1; return; }
        if (hipOccupancyMaxActiveBlocksPerMultiprocessor(&per_cu, (const void*)fwd_megakernel, NT, LDS_BYTES) != hipSuccess || per_cu < 1) { fprintf(stderr, "kernel_launch: occupancy query says %d blocks per CU\n", per_cu); per_cu = 1; }
        (void)hipGetLastError();
        grid = cus;
    }
    if (grid < 0) return;
    Args a{};
    a.x = (const float*)d_in[0]; a.norm1_g = (const float*)d_in[1]; a.w_in = (const float*)d_in[2]; a.conv_w = (const float*)d_in[3]; a.conv_b = (const float*)d_in[4];
    a.conv_ln_g = (const float*)d_in[5]; a.conv_ln_b = (const float*)d_in[6]; a.ret_norm_g = (const float*)d_in[7]; a.w_out = (const float*)d_in[8]; a.norm2_g = (const float*)d_in[9];
    a.w_ff1 = (const float*)d_in[10]; a.w_ff2 = (const float*)d_in[11]; a.final_g = (const float*)d_in[12];
    a.out = (float*)d_out; a.ws = (unsigned char*)d_ws;
#if MK_ONE_LAUNCH
    if (hipMemsetAsync((char*)d_ws + WS_BAR, 0, XCD_BAR_WORDS * 4, stream) != hipSuccess) { fprintf(stderr, "kernel_launch: memset failed\n"); return; }
    a.ph_lo = 0; a.ph_hi = N_PHASES; a.coop = 1;
    void* args[] = {&a};
    hipError_t e = hipLaunchCooperativeKernel((const void*)fwd_megakernel, dim3(grid), dim3(NT), args, LDS_BYTES, stream);
    if (e != hipSuccess) fprintf(stderr, "cooperative launch failed: %s (grid %d)\n", hipGetErrorString(e), grid);
#else
    for (int p = 0; p < N_PHASES; ++p) { a.ph_lo = p; a.ph_hi = p + 1; a.coop = 0;
        hipLaunchKernelGGL(fwd_megakernel, dim3(grid), dim3(NT), LDS_BYTES, stream, a); }
#endif
}
```
